# Optimizing an MI355X kernel written in HIP

```python
import math
import jax
import jax.numpy as jnp
from jax import lax
import numpy as np

D_MODEL = 1024
BATCH = 8
SEQ = 2048
DEPTH = 4

CTX_LEN = 256
GRID_W = 64
N_MIXERS = 4
N_GQA = (DEPTH + 3) // N_MIXERS
N_S5 = (DEPTH + 2) // N_MIXERS
N_SSD = (DEPTH + 1) // N_MIXERS
N_NA = DEPTH // N_MIXERS
N_MOD = 6
D_FF = 4 * D_MODEL
NORM_EPS = 1e-6

GQA_HEAD_DIM = 128
GQA_HEADS = D_MODEL // GQA_HEAD_DIM
GQA_KV_HEADS = 2
GQA_GROUP = GQA_HEADS // GQA_KV_HEADS
Q_BLOCK = 128
ROPE_THETA = 10000.0

S5_GROUP = 16
S5_GROUPS = D_MODEL // S5_GROUP
S5_STATE = 64
S5_DT_MIN = 0.001
S5_DT_MAX = 0.1

SSD_D_INNER = 2 * D_MODEL
SSD_HEAD_DIM = 64
SSD_HEADS = SSD_D_INNER // SSD_HEAD_DIM
SSD_GROUPS = 4
SSD_STATE = 128
SSD_CONV = 5
SSD_CHUNK = 128
SSD_CONV_CH = SSD_D_INNER + 2 * SSD_GROUPS * SSD_STATE
SSD_IN = SSD_D_INNER + SSD_CONV_CH + 2 * SSD_HEADS
SSD_DT_MIN = 0.001
SSD_DT_MAX = 0.1

NA_HEAD_DIM = 64
NA_HEADS = D_MODEL // NA_HEAD_DIM
NA_WIN_ROWS = 8
NA_WIN_COLS = 16

kernel_name = "hybrid_interleaved_flow_trunk"


def _rms(x, g):
    xf = x.astype(jnp.float32)
    y = xf * lax.rsqrt(jnp.mean(xf * xf, axis=-1, keepdims=True) + NORM_EPS)
    return (y * g.astype(jnp.float32)).astype(x.dtype)


def _mlp(h, w1, w2):
    return jnp.square(jax.nn.relu(h @ w1)) @ w2


def _attend(q, k, v):
    s = jnp.einsum("bqkgd,bskd->bkgqs", q, k, preferred_element_type=jnp.float32)
    p = jax.nn.softmax(s * (q.shape[-1] ** -0.5), axis=-1).astype(v.dtype)
    return jnp.einsum("bkgqs,bskd->bqkgd", p, v)


def _axial_rope_tables(n_tok, head_dim):
    pos = jnp.arange(n_tok)
    row = (pos // GRID_W).astype(jnp.float32)
    col = (pos % GRID_W).astype(jnp.float32)
    half = head_dim // 2
    inv_freq = 1.0 / (ROPE_THETA ** (jnp.arange(0, half, 2, dtype=jnp.float32) / half))
    ang_r = row[:, None] * inv_freq
    ang_c = col[:, None] * inv_freq
    return jnp.cos(ang_r), jnp.sin(ang_r), jnp.cos(ang_c), jnp.sin(ang_c)


def _rotate(x, cos, sin):
    x1, x2 = jnp.split(x, 2, axis=-1)
    cos = cos[None, :, None, :]
    sin = sin[None, :, None, :]
    return jnp.concatenate([x1 * cos - x2 * sin, x1 * sin + x2 * cos], axis=-1)


def _apply_axial_rope(x, tables):
    cr, sr, cc, sc = tables
    xf = x.astype(jnp.float32)
    half = x.shape[-1] // 2
    out = jnp.concatenate([_rotate(xf[..., :half], cr, sr), _rotate(xf[..., half:], cc, sc)], axis=-1)
    return out.astype(x.dtype)


def _gqa_mixer(hc, h, w_qkv, q_norm, k_norm, w_o, need_ctx):
    n_q = GQA_HEADS * GQA_HEAD_DIM

    def q_of(z):
        q = (z @ w_qkv[:, :n_q]).reshape(z.shape[:2] + (GQA_KV_HEADS, GQA_GROUP, GQA_HEAD_DIM))
        return _rms(q, q_norm)

    def kv_of(z):
        kv = (z @ w_qkv[:, n_q:]).reshape(z.shape[:2] + (2, GQA_KV_HEADS, GQA_HEAD_DIM))
        return _rms(kv[:, :, 0], k_norm), kv[:, :, 1]

    bsz, n_lat, _ = h.shape
    tables = _axial_rope_tables(n_lat, GQA_HEAD_DIM)
    q = _apply_axial_rope(q_of(h).reshape(bsz, n_lat, GQA_HEADS, GQA_HEAD_DIM), tables)
    k, v = kv_of(h)
    k = _apply_axial_rope(k, tables)
    kc, vc = kv_of(hc)
    k_all = jnp.concatenate([kc, k], axis=1)
    v_all = jnp.concatenate([vc, v], axis=1)
    q_blocks = jnp.moveaxis(
        q.reshape(bsz, n_lat // Q_BLOCK, Q_BLOCK, GQA_KV_HEADS, GQA_GROUP, GQA_HEAD_DIM), 1, 0)
    o = lax.map(lambda qb: _attend(qb, k_all, v_all), q_blocks)
    y = jnp.moveaxis(o, 0, 1).reshape(bsz, n_lat, n_q) @ w_o
    yc = None
    if need_ctx:
        yc = _attend(q_of(hc), kc, vc).reshape(hc.shape[0], hc.shape[1], n_q) @ w_o
    return yc, y


def _lin_combine(e1, e2):
    a1, b1 = e1
    a2, b2 = e2
    return a1 * a2, a2 * b1 + b2


def _s5_discretise(a_re, a_im, log_dt, b_re, b_im):
    lam = lax.complex(a_re.astype(jnp.float32), a_im.astype(jnp.float32))
    a_bar = jnp.exp(lam * jnp.exp(log_dt.astype(jnp.float32))[:, None])
    b = lax.complex(b_re.astype(jnp.float32), b_im.astype(jnp.float32))
    b_bar = ((a_bar - 1.0) / lam)[..., None] * b
    return a_bar, b_bar


def _s5_states(u, a_bar, b_bar, s0, reverse):
    bu = jnp.einsum("blgc,gpc->blgp", u, b_bar)
    if reverse:
        bu = jnp.flip(bu, 1)
    if s0 is not None:
        bu = bu.at[:, 0].add(a_bar * s0)
    a_seq = jnp.broadcast_to(a_bar, (1, bu.shape[1]) + a_bar.shape)
    _, st = lax.associative_scan(_lin_combine, (a_seq, bu), axis=1)
    return jnp.flip(st, 1) if reverse else st


def _s5_readout(st, c_re, c_im):
    c = lax.complex(c_re.astype(jnp.float32), c_im.astype(jnp.float32))
    y = jnp.einsum("blgp,gcp->blgc", st, c).real
    return y.reshape(st.shape[0], st.shape[1], D_MODEL)


def _s5_mixer(hc, h, a_re, a_im, log_dt, b_re, b_im, c_re, c_im, d_skip, glu_w, glu_b, need_ctx):
    bsz, n_lat, _ = h.shape
    hf = h.astype(jnp.float32)
    hcf = hc.astype(jnp.float32)
    u = hf.reshape(bsz, n_lat, S5_GROUPS, S5_GROUP).astype(jnp.complex64)
    uc = hcf.reshape(bsz, hc.shape[1], S5_GROUPS, S5_GROUP).astype(jnp.complex64)
    d = d_skip.astype(jnp.float32)
    y = hf * d
    yc = hcf * d if need_ctx else None
    for direction, reverse in ((0, False), (1, True)):
        a_bar, b_bar = _s5_discretise(a_re[direction], a_im[direction], log_dt[direction],
                                      b_re[direction], b_im[direction])
        st_c = _s5_states(uc, a_bar, b_bar, None, reverse)
        s_end = st_c[:, 0] if reverse else st_c[:, -1]
        st = _s5_states(u, a_bar, b_bar, s_end, reverse)
        y = y + _s5_readout(st, c_re[direction], c_im[direction])
        if need_ctx:
            yc = yc + _s5_readout(st_c, c_re[direction], c_im[direction])

    def glu(z):
        g = jax.nn.gelu(z).astype(h.dtype)
        return g * jax.nn.sigmoid(g @ glu_w + glu_b)

    yc_out = glu(yc) if need_ctx else None
    return yc_out, glu(y)


def _dwconv_centred(x, w, b):
    ch = x.shape[-1]
    width = w.shape[0]
    y = lax.conv_general_dilated(
        x, w.astype(x.dtype)[:, None, :], window_strides=(1,),
        padding=[(width // 2, width // 2)], dimension_numbers=("NWC", "WIO", "NWC"),
        feature_group_count=ch)
    return y + b.astype(x.dtype)


def _segsum_exp(a_cum):
    t = a_cum.shape[-1]
    diff = a_cum[..., :, None] - a_cum[..., None, :]
    mask = jnp.tril(jnp.ones((t, t), dtype=bool))
    return jnp.exp(jnp.where(mask, diff, -jnp.inf))


def _ssd_chunked(xs, dt, a, bm, cm, h0, need_y):
    bsz, n, nh, hp = xs.shape
    ng, ns = bm.shape[-2:]
    nj = nh // ng
    nc = n // SSD_CHUNK
    xdt = (xs * dt[..., None]).reshape(bsz, nc, SSD_CHUNK, ng, nj, hp)
    a_cum = jnp.cumsum(
        jnp.moveaxis((dt * a).reshape(bsz, nc, SSD_CHUNK, ng, nj), (1, 2), (3, 4)), axis=-1)
    bm = bm.reshape(bsz, nc, SSD_CHUNK, ng, ns)
    cm = cm.reshape(bsz, nc, SSD_CHUNK, ng, ns)
    decay_states = jnp.exp(a_cum[..., -1:] - a_cum)
    states = jnp.einsum("bclgn,bgjcl,bclgjp->bcgjpn", bm, decay_states, xdt)
    states = jnp.concatenate([h0.reshape(bsz, 1, ng, nj, hp, ns), states], axis=1)
    chunk_cum = jnp.cumsum(jnp.pad(a_cum[..., -1], ((0, 0), (0, 0), (0, 0), (1, 0))), axis=-1)
    decay_chunk = _segsum_exp(chunk_cum)
    new_states = jnp.einsum("bgjzc,bcgjpn->bzgjpn", decay_chunk, states)
    h_final = new_states[:, -1].reshape(bsz, nh, hp, ns)
    if not need_y:
        return None, h_final
    lmat = _segsum_exp(a_cum)
    scores = jnp.einsum("bclgn,bcsgn->bgcls", cm, bm)
    y_diag = jnp.einsum("bgcls,bgjcls,bcsgjp->bclgjp", scores, lmat, xdt)
    y_off = jnp.einsum("bclgn,bcgjpn,bgjcl->bclgjp", cm, new_states[:, :-1], jnp.exp(a_cum))
    return (y_diag + y_off).reshape(bsz, n, nh, hp), h_final


def _flip_if(t, reverse):
    return jnp.flip(t, 1) if reverse else t


def _ssd_mixer(hc, h, w_in, conv_w, conv_b, dt_bias, a_log, d_skip, norm_g, w_out, need_ctx):
    nbc = SSD_GROUPS * SSD_STATE

    def prep(z, with_gate):
        bz, lz, _ = z.shape
        proj = z @ w_in[:, SSD_D_INNER:]
        xbc = jax.nn.silu(_dwconv_centred(proj[..., :SSD_CONV_CH], conv_w, conv_b)).astype(jnp.float32)
        xs = xbc[..., :SSD_D_INNER].reshape(bz, lz, SSD_HEADS, SSD_HEAD_DIM)
        bm = xbc[..., SSD_D_INNER:SSD_D_INNER + nbc].reshape(bz, lz, SSD_GROUPS, SSD_STATE)
        cm = xbc[..., SSD_D_INNER + nbc:].reshape(bz, lz, SSD_GROUPS, SSD_STATE)
        dt = jax.nn.softplus(proj[..., SSD_CONV_CH:].astype(jnp.float32).reshape(bz, lz, 2, SSD_HEADS)
                             + dt_bias.astype(jnp.float32))
        gate = z @ w_in[:, :SSD_D_INNER] if with_gate else None
        return gate, xs, bm, cm, dt

    gate, xs, bm, cm, dt = prep(h, True)
    gate_c, xs_c, bm_c, cm_c, dt_c = prep(hc, need_ctx)
    a = -jnp.exp(a_log.astype(jnp.float32))
    d = d_skip.astype(jnp.float32)[:, None]
    y = xs * d
    yc = xs_c * d if need_ctx else None
    h0 = jnp.zeros((h.shape[0], SSD_HEADS, SSD_HEAD_DIM, SSD_STATE), jnp.float32)
    for direction, reverse in ((0, False), (1, True)):
        y_c, s_c = _ssd_chunked(_flip_if(xs_c, reverse), _flip_if(dt_c[:, :, direction], reverse), a[direction],
                                _flip_if(bm_c, reverse), _flip_if(cm_c, reverse), h0, need_ctx)
        y_l, _ = _ssd_chunked(_flip_if(xs, reverse), _flip_if(dt[:, :, direction], reverse), a[direction],
                              _flip_if(bm, reverse), _flip_if(cm, reverse), s_c, True)
        y = y + _flip_if(y_l, reverse)
        if need_ctx:
            yc = yc + _flip_if(y_c, reverse)

    def out(yy, gt):
        bz, lz = yy.shape[:2]
        yg = yy.reshape(bz, lz, SSD_D_INNER) * jax.nn.silu(gt.astype(jnp.float32))
        yg = _rms(yg.reshape(bz, lz, SSD_GROUPS, SSD_D_INNER // SSD_GROUPS),
                  norm_g.reshape(SSD_GROUPS, SSD_D_INNER // SSD_GROUPS))
        return yg.reshape(bz, lz, SSD_D_INNER).astype(h.dtype) @ w_out

    yc_out = out(yc, gate_c) if need_ctx else None
    return yc_out, out(y, gate)


def _na_mixer(hc, h, w_qkv, rpb, w_o, need_ctx):
    bsz, n_lat, _ = h.shape
    rows = n_lat // GRID_W
    wr = min(NA_WIN_ROWS, rows)
    n_loc = wr * NA_WIN_COLS
    scale = NA_HEAD_DIM ** -0.5

    def q_of(z):
        return (z @ w_qkv[:, :D_MODEL]).reshape(z.shape[:2] + (NA_HEADS, NA_HEAD_DIM))

    def kv_of(z):
        kv = (z @ w_qkv[:, D_MODEL:]).reshape(z.shape[:2] + (2, NA_HEADS, NA_HEAD_DIM))
        return kv[:, :, 0], kv[:, :, 1]

    k, v = kv_of(h)
    kc, vc = kv_of(hc)
    k_grid = k.reshape(bsz, rows, GRID_W, NA_HEADS, NA_HEAD_DIM)
    v_grid = v.reshape(bsz, rows, GRID_W, NA_HEADS, NA_HEAD_DIM)
    q_rows = jnp.moveaxis(q_of(h).reshape(bsz, rows, GRID_W, NA_HEADS, NA_HEAD_DIM), 1, 0)
    cols = np.arange(GRID_W)
    col_start = np.clip(cols - NA_WIN_COLS // 2, 0, GRID_W - NA_WIN_COLS)
    col_idx = col_start[:, None] + np.arange(NA_WIN_COLS)[None, :]
    col_rel = col_idx - cols[:, None] + (NA_WIN_COLS - 1)

    def row_attend(args):
        r, q_row = args
        r0 = jnp.clip(r - wr // 2, 0, rows - wr)
        k_win = lax.dynamic_slice_in_dim(k_grid, r0, wr, axis=1)[:, :, col_idx]
        v_win = lax.dynamic_slice_in_dim(v_grid, r0, wr, axis=1)[:, :, col_idx]
        row_rel = r0 + jnp.arange(wr) - r + (NA_WIN_ROWS - 1)
        bias = rpb[:, row_rel[None, :, None], col_rel[:, None, :]]
        s_loc = jnp.einsum("bqhd,brqchd->bhqrc", q_row, k_win, preferred_element_type=jnp.float32) * scale
        s_loc = s_loc + bias.astype(jnp.float32)[None]
        s_ctx = jnp.einsum("bqhd,bshd->bhqs", q_row, kc, preferred_element_type=jnp.float32) * scale
        p = jax.nn.softmax(
            jnp.concatenate([s_loc.reshape(bsz, NA_HEADS, GRID_W, n_loc), s_ctx], axis=-1), axis=-1
        ).astype(v.dtype)
        p_loc = p[..., :n_loc].reshape(bsz, NA_HEADS, GRID_W, wr, NA_WIN_COLS)
        return (jnp.einsum("bhqrc,brqchd->bqhd", p_loc, v_win)
                + jnp.einsum("bhqs,bshd->bqhd", p[..., n_loc:], vc))

    o = lax.map(row_attend, (jnp.arange(rows), q_rows))
    y = jnp.moveaxis(o, 0, 1).reshape(bsz, n_lat, D_MODEL) @ w_o
    yc = None
    if need_ctx:
        yc = _attend(q_of(hc)[:, :, :, None], kc, vc).reshape(hc.shape[0], hc.shape[1], D_MODEL) @ w_o
    return yc, y


def setup_inputs(seed: int = 0) -> dict:
    key = jax.random.key(seed)
    keys = iter(jax.random.split(key, 48))
    f32 = jnp.float32

    def nrm(shape, scale=1.0):
        return jax.random.normal(next(keys), shape, f32) * scale

    def unif(shape, lo, hi):
        return jax.random.uniform(next(keys), shape, f32, lo, hi)

    d = D_MODEL
    s5_shape = (N_S5, 2, S5_GROUPS, S5_STATE)
    n_q = GQA_HEADS * GQA_HEAD_DIM
    ssd_dt = jnp.exp(unif((N_SSD, 2, SSD_HEADS), math.log(SSD_DT_MIN), math.log(SSD_DT_MAX)))
    return {
        "x": nrm((BATCH, SEQ, d)),
        "c": nrm((BATCH, d)),
        "ctx": nrm((BATCH, CTX_LEN, d)),
        "c_ctx": nrm((d,)),
        "ada_w": nrm((DEPTH, d, N_MOD * d), d ** -0.5),
        "ada_b": nrm((DEPTH, N_MOD * d), 0.02),
        "norm_g": 1.0 + nrm((DEPTH, 4, d), 0.05),
        "mlp_w1": nrm((DEPTH, d, D_FF), d ** -0.5),
        "mlp_w2": nrm((DEPTH, D_FF, d), D_FF ** -0.5),
        "gqa_w_qkv": nrm((N_GQA, d, n_q + 2 * GQA_KV_HEADS * GQA_HEAD_DIM), d ** -0.5),
        "gqa_q_norm": 1.0 + nrm((N_GQA, GQA_HEAD_DIM), 0.05),
        "gqa_k_norm": 1.0 + nrm((N_GQA, GQA_HEAD_DIM), 0.05),
        "gqa_w_o": nrm((N_GQA, n_q, d), n_q ** -0.5),
        "s5_a_re": -0.5 * jnp.exp(nrm(s5_shape, 0.02)),
        "s5_a_im": jnp.broadcast_to(jnp.pi * jnp.arange(S5_STATE, dtype=f32), s5_shape),
        "s5_log_dt": unif((N_S5, 2, S5_GROUPS), math.log(S5_DT_MIN), math.log(S5_DT_MAX)),
        "s5_b_re": nrm((N_S5, 2, S5_GROUPS, S5_STATE, S5_GROUP), (2 * S5_GROUP) ** -0.5),
        "s5_b_im": nrm((N_S5, 2, S5_GROUPS, S5_STATE, S5_GROUP), (2 * S5_GROUP) ** -0.5),
        "s5_c_re": nrm((N_S5, 2, S5_GROUPS, S5_GROUP, S5_STATE), (2 * S5_STATE) ** -0.5),
        "s5_c_im": nrm((N_S5, 2, S5_GROUPS, S5_GROUP, S5_STATE), (2 * S5_STATE) ** -0.5),
        "s5_d": nrm((N_S5, d)),
        "s5_glu_w": nrm((N_S5, d, d), d ** -0.5),
        "s5_glu_b": nrm((N_S5, d), 0.02),
        "ssd_w_in": nrm((N_SSD, d, SSD_IN), d ** -0.5),
        "ssd_conv_w": nrm((N_SSD, SSD_CONV, SSD_CONV_CH), SSD_CONV ** -0.5),
        "ssd_conv_b": nrm((N_SSD, SSD_CONV_CH), 0.02),
        "ssd_dt_bias": ssd_dt + jnp.log(-jnp.expm1(-ssd_dt)),
        "ssd_a_log": jnp.log(unif((N_SSD, 2, SSD_HEADS), 1.0, 16.0)),
        "ssd_d": 1.0 + nrm((N_SSD, SSD_HEADS), 0.05),
        "ssd_norm_g": 1.0 + nrm((N_SSD, SSD_D_INNER), 0.05),
        "ssd_w_out": nrm((N_SSD, SSD_D_INNER, d), SSD_D_INNER ** -0.5),
        "na_w_qkv": nrm((N_NA, d, 3 * d), d ** -0.5),
        "na_rpb": nrm((N_NA, NA_HEADS, 2 * NA_WIN_ROWS - 1, 2 * NA_WIN_COLS - 1), 0.02),
        "na_w_o": nrm((N_NA, d, d), d ** -0.5),
    }


def reference(x, c, ctx, c_ctx, ada_w, ada_b, norm_g, mlp_w1, mlp_w2,
              gqa_w_qkv, gqa_q_norm, gqa_k_norm, gqa_w_o,
              s5_a_re, s5_a_im, s5_log_dt, s5_b_re, s5_b_im, s5_c_re, s5_c_im, s5_d, s5_glu_w, s5_glu_b,
              ssd_w_in, ssd_conv_w, ssd_conv_b, ssd_dt_bias, ssd_a_log, ssd_d, ssd_norm_g, ssd_w_out,
              na_w_qkv, na_rpb, na_w_o):
    bsz = x.shape[0]
    xc = ctx
    silu_c = jax.nn.silu(c)
    silu_cc = jax.nn.silu(c_ctx)
    for i in range(DEPTH):
        kind = i % N_MIXERS
        j = i // N_MIXERS
        need_ctx = i < DEPTH - 1
        mod = (silu_c @ ada_w[i] + ada_b[i]).reshape(bsz, N_MOD, 1, D_MODEL)
        modc = (silu_cc @ ada_w[i] + ada_b[i]).reshape(N_MOD, D_MODEL)
        g = norm_g[i]
        h = _rms(x, g[0]) * (1.0 + mod[:, 1]) + mod[:, 0]
        hc = _rms(xc, g[0]) * (1.0 + modc[1]) + modc[0]
        if kind == 0:
            yc, y = _gqa_mixer(hc, h, gqa_w_qkv[j], gqa_q_norm[j], gqa_k_norm[j], gqa_w_o[j], need_ctx)
        elif kind == 1:
            yc, y = _s5_mixer(hc, h, s5_a_re[j], s5_a_im[j], s5_log_dt[j], s5_b_re[j], s5_b_im[j],
                              s5_c_re[j], s5_c_im[j], s5_d[j], s5_glu_w[j], s5_glu_b[j], need_ctx)
        elif kind == 2:
            yc, y = _ssd_mixer(hc, h, ssd_w_in[j], ssd_conv_w[j], ssd_conv_b[j], ssd_dt_bias[j],
                               ssd_a_log[j], ssd_d[j], ssd_norm_g[j], ssd_w_out[j], need_ctx)
        else:
            yc, y = _na_mixer(hc, h, na_w_qkv[j], na_rpb[j], na_w_o[j], need_ctx)
        x = x + mod[:, 2] * _rms(y, g[1])
        h = _rms(x, g[2]) * (1.0 + mod[:, 4]) + mod[:, 3]
        x = x + mod[:, 5] * _rms(_mlp(h, mlp_w1[i], mlp_w2[i]), g[3])
        if need_ctx:
            xc = xc + modc[2] * _rms(yc, g[1])
            hc = _rms(xc, g[2]) * (1.0 + modc[4]) + modc[3]
            xc = xc + modc[5] * _rms(_mlp(hc, mlp_w1[i], mlp_w2[i]), g[3])
    return x
```

```cpp
#include <hip/hip_runtime.h>
#include <hip/hip_cooperative_groups.h>
#include <cstdio>
#include <cstdint>
namespace cg = cooperative_groups;

#ifndef MK_MULTI
#define MK_MULTI 0
#endif

typedef unsigned short bf16_t;
typedef short bf16x8_t __attribute__((ext_vector_type(8)));
typedef short s16x4_t __attribute__((ext_vector_type(4)));
typedef float f32x4_t __attribute__((ext_vector_type(4)));

constexpr int DM = 1024, NB = 8, SEQ = 2048, CTXL = 256, TT = 2304, MR = NB * TT, DFF = 4096;
constexpr float EPS = 1e-6f;
constexpr size_t MiB = 1024ull * 1024ull;
constexpr size_t WS_XC = 0;
constexpr size_t WS_MOD = 8 * MiB;
constexpr size_t WS_S5A = 9 * MiB;
constexpr size_t WS_DT = 11 * MiB;
constexpr size_t WS_WT = 16 * MiB;
constexpr size_t WT_W1 = WS_WT;
constexpr size_t WT_W2 = WT_W1 + 32 * MiB;
constexpr size_t WT_GQKV = WT_W2 + 32 * MiB;
constexpr size_t WT_GO = WT_GQKV + 3 * MiB;
constexpr size_t WT_GLU = WT_GO + 2 * MiB;
constexpr size_t WT_SIN1 = WT_GLU + 2 * MiB;
constexpr size_t WT_SGATE = WT_SIN1 + 13 * MiB / 2;
constexpr size_t WT_SOUT = WT_SGATE + 4 * MiB;
constexpr size_t WT_NQKV = WT_SOUT + 4 * MiB;
constexpr size_t WT_NO = WT_NQKV + 6 * MiB;
constexpr size_t WS_H = WT_NO + 2 * MiB;
constexpr size_t WS_BIG = WS_H + 36 * MiB;
constexpr size_t WS_END = WS_BIG + 225 * MiB;
constexpr int SSD_N1 = 3328;

__device__ __forceinline__ float bf2f(bf16_t v) { return __uint_as_float(((unsigned)v) << 16); }
__device__ __forceinline__ bf16_t f2bf(float f) { unsigned u = __float_as_uint(f); u += 0x7FFFu + ((u >> 16) & 1u); return (bf16_t)(u >> 16); }
__device__ __forceinline__ unsigned short f2bf_att(float f) { return f2bf(f); }
__device__ __forceinline__ unsigned pk2(float lo, float hi) { return (unsigned)f2bf(lo) | ((unsigned)f2bf(hi) << 16); }
__device__ __forceinline__ float wave_sum(float v) {
#pragma unroll
  for (int o = 32; o >= 1; o >>= 1) v += __shfl_xor(v, o);
  return v;
}
__device__ __forceinline__ void unpack8(uint4 v, float* f) {
  f[0] = __uint_as_float(v.x << 16); f[1] = __uint_as_float(v.x & 0xffff0000u);
  f[2] = __uint_as_float(v.y << 16); f[3] = __uint_as_float(v.y & 0xffff0000u);
  f[4] = __uint_as_float(v.z << 16); f[5] = __uint_as_float(v.z & 0xffff0000u);
  f[6] = __uint_as_float(v.w << 16); f[7] = __uint_as_float(v.w & 0xffff0000u);
}
__device__ __forceinline__ uint4 pack8(const float* f) {
  uint4 v; v.x = pk2(f[0], f[1]); v.y = pk2(f[2], f[3]); v.z = pk2(f[4], f[5]); v.w = pk2(f[6], f[7]); return v;
}
__device__ __forceinline__ float silu_f(float x) { return x / (1.0f + __expf(-x)); }

struct Params {
  const float* in[34];
  float* out;
  unsigned char* ws;
  int ph_lo, ph_hi;
};
namespace pg8 {
#define PG8_LAS __attribute__((address_space(3)))
typedef unsigned short bf16_t;
typedef short bf16x8 __attribute__((ext_vector_type(8)));
typedef float f32x4 __attribute__((ext_vector_type(4)));
typedef unsigned u32x4 __attribute__((ext_vector_type(4)));
constexpr int BM = 256, BK = 64, HALF = 128, HTB = HALF * BK * 2  , STAGE_BYTES = 8 * HTB, NXCD = 8, WGM = 8;

__host__ __device__ __forceinline__ int lds_byte(int r, int c) { const int st = (r >> 4) * 2 + (c >> 5), rr = r & 15, cc = c & 31, ob = rr * 64 + cc * 2; return st * 1024 + (ob ^ (((ob >> 9) & 1) << 5)); }
__host__ __device__ __forceinline__ void stage_rc(int b, int& R, int& C) { const int st = b / 1024, sb = b % 1024, swz = sb ^ (((sb >> 9) & 1) << 5); R = (st >> 1) * 16 + swz / 64; C = (st & 1) * 32 + (swz % 64) / 2; }
__host__ __device__ __forceinline__ int perm32(int rho) { const int n = rho >> 4, i = rho & 15; return 8 * (i >> 2) + 4 * n + (i & 3); }

struct Unit { int pm, pn; };
struct Gemm { const bf16_t* A; const bf16_t* Bt; int M, N, K; };

struct StaticOrder {
    int nM, nN, nwg, G, c;
    __host__ __device__ void init(int M, int N, int G_, int c_) { nM = M / BM; nN = N / BM; nwg = nM * nN; G = G_; c = c_; }
    __host__ __device__ bool next(int i, Unit& u) const {
        const long L = (long)i * G + c; if (L >= nwg) return false;
        int wgid = (int)L; { const int q = nwg / NXCD, r = nwg % NXCD, xcd = wgid % NXCD, off = wgid / NXCD; wgid = (xcd < r ? xcd * (q + 1) : r * (q + 1) + (xcd - r) * q) + off; }
        const int nig = WGM * nN, gid = wgid / nig, fm = gid * WGM, gsz = (nM - fm) < WGM ? (nM - fm) : WGM;
        u.pm = fm + ((wgid % nig) % gsz); u.pn = (wgid % nig) / gsz; return true;
    }
    __device__ __forceinline__ void a_ready(const Unit&) const {}
    __device__ __forceinline__ void done(const Unit&) const {}
};
__device__ __forceinline__ unsigned cvt_pk_bf16(float lo, float hi) { unsigned r; asm volatile("v_cvt_pk_bf16_f32 %0, %1, %2" : "=v"(r) : "v"(lo), "v"(hi)); return r; }
typedef float f32x2 __attribute__((ext_vector_type(2)));
template <int ACT> struct EpiB {
    static constexpr bool PERM = true, AFTER_DRAIN = false;
    bf16_t* O; int ldc; const float* bias; const bf16_t* aux;
    __device__ __forceinline__ void operator()(const f32x4 (&acc)[2][2][4][2], const Unit& u, int wr, int wc, int fr, int fq) const {
        const int row0 = u.pm * BM + wr * 64 + fr; const int col0 = u.pn * BM + wc * 32 + 8 * fq;
#pragma unroll
        for (int ai = 0; ai < 2; ++ai)
#pragma unroll
            for (int m = 0; m < 4; ++m) { const size_t roff = (size_t)(row0 + ai * HALF + m * 16) * ldc + col0;
#pragma unroll
                for (int bj = 0; bj < 2; ++bj) { f32x4 v0 = acc[ai][bj][m][0], v1 = acc[ai][bj][m][1];
                    if (ACT == 1) {
#pragma unroll
                        for (int j = 0; j < 4; ++j) { float a = v0[j] > 0.f ? v0[j] : 0.f; v0[j] = a * a; float b = v1[j] > 0.f ? v1[j] : 0.f; v1[j] = b * b; } }
                    if (ACT == 2) {
                        const f32x4 b0 = *(const f32x4*)(bias + col0 + bj * HALF), b1 = *(const f32x4*)(bias + col0 + bj * HALF + 4);
                        const u32x4 g = *(const u32x4*)(aux + roff + bj * HALF);
                        float gf[8]; gf[0] = __uint_as_float(g.x << 16); gf[1] = __uint_as_float(g.x & 0xffff0000u); gf[2] = __uint_as_float(g.y << 16); gf[3] = __uint_as_float(g.y & 0xffff0000u);
                        gf[4] = __uint_as_float(g.z << 16); gf[5] = __uint_as_float(g.z & 0xffff0000u); gf[6] = __uint_as_float(g.w << 16); gf[7] = __uint_as_float(g.w & 0xffff0000u);
#pragma unroll
                        for (int j = 0; j < 4; ++j) { v0[j] = gf[j] / (1.0f + __expf(-(v0[j] + b0[j]))); v1[j] = gf[4 + j] / (1.0f + __expf(-(v1[j] + b1[j]))); } }
                    u32x4 w; w.x = cvt_pk_bf16(v0[0], v0[1]); w.y = cvt_pk_bf16(v0[2], v0[3]); w.z = cvt_pk_bf16(v1[0], v1[1]); w.w = cvt_pk_bf16(v1[2], v1[3]);
                    *(u32x4*)(O + roff + bj * HALF) = w; } }
    }
};
template <class Epi, class Sched, bool STAMP = false>
__device__ __forceinline__ void gemm_phase(PG8_LAS unsigned char* lds, const Gemm g, const Sched& S, const Epi& E, unsigned long long* stamps) {
    const int tid = threadIdx.x, wid = __builtin_amdgcn_readfirstlane(tid >> 6), lane = tid & 63, wr = wid >> 2, wc = wid & 3, fr = lane & 15, fq = lane >> 4;
    const int K = g.K, nt = K / BK;
    int ts_lo = 0, ts_hi = 0, nts = 0; const unsigned long long rt_entry = STAMP ? (unsigned long long)wall_clock64() : 0ull;
#define PG8_STAMP() do { if (STAMP && wid == 0 && nts < 64) { const unsigned long long _c = (unsigned long long)clock64(); \
        ts_lo = (lane == nts) ? (int)(unsigned)_c : ts_lo; ts_hi = (lane == nts) ? (int)(unsigned)(_c >> 32) : ts_hi; ++nts; } } while (0)
    PG8_STAMP();
    unsigned voffA[2], voffB[2];
#pragma unroll
    for (int i = 0; i < 2; ++i) { int R, C; stage_rc(tid * 16 + i * 8192, R, C); const int Rb = Epi::PERM ? ((R & ~31) + perm32(R & 31)) : R;
        voffA[i] = (unsigned)(R * K + C) * 2u; voffB[i] = (unsigned)(Rb * K + C) * 2u; }
    const size_t kstep = (size_t)(BK * 2);
    const size_t hstep = (size_t)HALF * K * 2;
    const size_t tstep = 2 * hstep;
    const unsigned ldsw = (unsigned)wid * 1024u;
    const int aoff = lds_byte(wr * 64 + fr, fq * 8), boff = lds_byte(wc * 32 + fr, fq * 8);
#define PG8_SA(b, h) (((b) * 2 + (h)) * HTB)
#define PG8_SB(b, h) ((4 + (b) * 2 + (h)) * HTB)
#define PG8_STAGE(bufoff, gbase, voff) do { _Pragma("unroll") for (int _i = 0; _i < 2; ++_i) \
        __builtin_amdgcn_global_load_lds((const unsigned*)((const char*)(gbase) + (voff)[_i]), (PG8_LAS unsigned*)(lds + (bufoff) + ldsw + _i * 8192), 16, 0, 0); } while (0)
#define PG8_LDA(dst, b, h) do { _Pragma("unroll") for (int m = 0; m < 4; ++m) _Pragma("unroll") for (int k = 0; k < 2; ++k) dst[m][k] = *(const PG8_LAS bf16x8*)(lds + PG8_SA(b, h) + aoff + m * 2048 + k * 1024); } while (0)
#define PG8_LDB(dst, b, h) do { _Pragma("unroll") for (int n = 0; n < 2; ++n) _Pragma("unroll") for (int k = 0; k < 2; ++k) dst[n][k] = *(const PG8_LAS bf16x8*)(lds + PG8_SB(b, h) + boff + n * 2048 + k * 1024); } while (0)
#define PG8_MMA(ai, bj, At, Bt) do { __builtin_amdgcn_s_setprio(1); _Pragma("unroll") for (int m = 0; m < 4; ++m) _Pragma("unroll") for (int n = 0; n < 2; ++n) _Pragma("unroll") for (int k = 0; k < 2; ++k) \
        acc[ai][bj][m][n] = __builtin_amdgcn_mfma_f32_16x16x32_bf16(Bt[n][k], At[m][k], acc[ai][bj][m][n], 0, 0, 0); __builtin_amdgcn_s_setprio(0); } while (0)
#define PG8_WAIT_V(n) asm volatile("s_waitcnt vmcnt(" #n ")" ::: "memory")
#define PG8_WAIT_L(n) asm volatile("s_waitcnt lgkmcnt(" #n ")" ::: "memory")
#define PG8_BAR __builtin_amdgcn_s_barrier()
#define PG8_SCHED __builtin_amdgcn_sched_barrier(0)
    Unit cur, nxt; int ui = 0;
    if (!S.next(0, cur)) return;
    f32x4 acc[2][2][4][2];
#pragma unroll
    for (int a = 0; a < 2; ++a)
#pragma unroll
        for (int b = 0; b < 2; ++b)
#pragma unroll
            for (int m = 0; m < 4; ++m)
#pragma unroll
                for (int n = 0; n < 2; ++n) acc[a][b][m][n] = (f32x4){0.f, 0.f, 0.f, 0.f};
    bf16x8 At[4][2], B0[2][2], B1[2][2];
    const char* cA = (const char*)g.A + (size_t)cur.pm * tstep; const char* cB = (const char*)g.Bt + (size_t)cur.pn * tstep;
    S.a_ready(cur);
    PG8_STAGE(PG8_SB(0, 0), cB, voffB); PG8_STAGE(PG8_SA(0, 0), cA, voffA); PG8_STAGE(PG8_SB(0, 1), cB + hstep, voffB); PG8_STAGE(PG8_SA(0, 1), cA + hstep, voffA);
    if (wr == 1) PG8_BAR;
    PG8_WAIT_V(4); PG8_BAR;
    PG8_STAGE(PG8_SB(1, 0), cB + kstep, voffB); PG8_STAGE(PG8_SA(1, 0), cA + kstep, voffA); PG8_STAGE(PG8_SB(1, 1), cB + hstep + kstep, voffB);
    PG8_WAIT_V(6); PG8_BAR;
    PG8_STAMP();
    for (;;) {
        const bool has_next = S.next(ui + 1, nxt);
        const char* nA = has_next ? (const char*)g.A + (size_t)nxt.pm * tstep : cA; const char* nB = has_next ? (const char*)g.Bt + (size_t)nxt.pn * tstep : cB;
        for (int t = 0; t < nt; t += 2) {
            const bool last = (t == nt - 2);
            const char* a1 = cA + (size_t)(t + 1) * kstep;
            const char* a2 = last ? nA : cA + (size_t)(t + 2) * kstep; const char* b2 = last ? nB : cB + (size_t)(t + 2) * kstep;
            const char* a3 = a2 + kstep; const char* b3 = b2 + kstep;
            if (last && has_next) S.a_ready(nxt);
            PG8_LDB(B0, 0, 0); PG8_SCHED; PG8_LDA(At, 0, 0); PG8_STAGE(PG8_SA(1, 1), a1 + hstep, voffA);
            PG8_WAIT_L(8); PG8_BAR; PG8_WAIT_L(0); PG8_MMA(0, 0, At, B0); PG8_BAR; PG8_SCHED;
            PG8_LDB(B1, 0, 1); PG8_STAGE(PG8_SB(0, 0), b2, voffB);
            PG8_BAR; PG8_WAIT_L(0); PG8_MMA(0, 1, At, B1); PG8_BAR;
            PG8_LDA(At, 0, 1); PG8_STAGE(PG8_SA(0, 0), a2, voffA);
            PG8_BAR; PG8_WAIT_L(0); PG8_MMA(1, 0, At, B0); PG8_BAR; PG8_SCHED;
            PG8_STAGE(PG8_SB(0, 1), b2 + hstep, voffB);
            PG8_WAIT_V(6); PG8_BAR; PG8_MMA(1, 1, At, B1); PG8_BAR;
            PG8_LDB(B0, 1, 0); PG8_SCHED; PG8_LDA(At, 1, 0); PG8_STAGE(PG8_SA(0, 1), a2 + hstep, voffA);
            PG8_WAIT_L(8); PG8_BAR; PG8_WAIT_L(0); PG8_MMA(0, 0, At, B0); PG8_BAR; PG8_SCHED;
            PG8_LDB(B1, 1, 1); PG8_STAGE(PG8_SB(1, 0), b3, voffB);
            PG8_BAR; PG8_WAIT_L(0); PG8_MMA(0, 1, At, B1); PG8_BAR;
            PG8_LDA(At, 1, 1); PG8_STAGE(PG8_SA(1, 0), a3, voffA);
            PG8_BAR; PG8_WAIT_L(0); PG8_MMA(1, 0, At, B0); PG8_BAR; PG8_SCHED;
            PG8_STAGE(PG8_SB(1, 1), b3 + hstep, voffB);
            PG8_WAIT_V(6); PG8_BAR; PG8_MMA(1, 1, At, B1); PG8_BAR;
        }
        PG8_STAMP();
        if constexpr (!Epi::AFTER_DRAIN) { E(acc, cur, wr, wc, fr, fq); S.done(cur); }
        PG8_STAMP();
        if (!has_next) break;
#pragma unroll
        for (int a = 0; a < 2; ++a)
#pragma unroll
            for (int b = 0; b < 2; ++b)
#pragma unroll
                for (int m = 0; m < 4; ++m)
#pragma unroll
                    for (int n = 0; n < 2; ++n) acc[a][b][m][n] = (f32x4){0.f, 0.f, 0.f, 0.f};
        cur = nxt; cA = nA; cB = nB; ++ui;
    }
    PG8_WAIT_V(0);
    if (wr == 0) PG8_BAR;
    PG8_BAR;
    if constexpr (Epi::AFTER_DRAIN) { E.fused(acc, cur, wr, wc, fr, fq, lds, wid, lane); S.done(cur); }
    PG8_STAMP();
    if (STAMP && wid == 0) { stamps[lane] = lane < nts ? (((unsigned long long)(unsigned)ts_hi << 32) | (unsigned)ts_lo) : 0ull;
        if (lane == 62) stamps[62] = rt_entry; if (lane == 63) stamps[63] = (unsigned long long)wall_clock64(); }
#undef PG8_STAMP
#undef PG8_SA
#undef PG8_SB
#undef PG8_STAGE
#undef PG8_LDA
#undef PG8_LDB
#undef PG8_MMA
#undef PG8_WAIT_V
#undef PG8_WAIT_L
#undef PG8_BAR
#undef PG8_SCHED
}
}
namespace att {
using bf16 = unsigned short;
constexpr int   D = 128, NW = 8, QBLK = 32, KVBLK = 64;
constexpr float SCALE = 0.088388347648318440f;
constexpr float THR = 8.f;
constexpr int SDEPTH = 2;
constexpr int LDQ = 1536, LDK = 1536, LDO = 1024;
constexpr size_t SHM_V = KVBLK * D * 2, SHM_K = KVBLK * D * 2, SHM_ATTN = 2 * SHM_V + 2 * SHM_K + NW * 64 * 4;
using bf16x8 = __attribute__((ext_vector_type(8))) short;
using s16x4  = __attribute__((ext_vector_type(4))) short;
using f32x16 = __attribute__((ext_vector_type(16))) float;
using f32x8  = __attribute__((ext_vector_type(8))) float;
using u32x4  = __attribute__((ext_vector_type(4))) unsigned;
#define KSWZ(row, colB) ((row) * 256 + ((colB) ^ (((row) & 7) << 4)))
#define SBAR() __builtin_amdgcn_sched_barrier(0)
__device__ __forceinline__ int crow(int r, int hi) { return (r & 3) + 8 * (r >> 2) + 4 * hi; }
__device__ __forceinline__ unsigned cvtpk(float lo, float hi) {
  unsigned r; asm volatile("v_cvt_pk_bf16_f32 %0, %1, %2" : "=v"(r) : "v"(lo), "v"(hi)); return r;
}
template <typename TIn> struct Stage;
template <> struct Stage<bf16>  { using T = bf16x8;
  __device__ static __forceinline__ T ld8(const bf16* p) { return *reinterpret_cast<const bf16x8*>(p); }
  __device__ static __forceinline__ bf16x8 tobf(T x) { return x; } };
template <> struct Stage<float> { using T = f32x8;
  __device__ static __forceinline__ T ld8(const float* p) { return *reinterpret_cast<const f32x8*>(p); }
  __device__ static __forceinline__ bf16x8 tobf(T x) {
    u32x4 w = {cvtpk(x[0], x[1]), cvtpk(x[2], x[3]), cvtpk(x[4], x[5]), cvtpk(x[6], x[7])}; return *reinterpret_cast<bf16x8*>(&w); } };

__device__ __forceinline__ void partialSM(f32x16& p0, f32x16& p1, float& m_reg, float& mn, float& alpha) {
  constexpr float C = SCALE * 1.4426950408889634f;
  float pmax = p0[0]; for (int r = 1; r < 16; ++r) pmax = fmaxf(pmax, p0[r]); for (int r = 0; r < 16; ++r) pmax = fmaxf(pmax, p1[r]);
  { auto rr = __builtin_amdgcn_permlane32_swap(__float_as_uint(pmax), __float_as_uint(pmax), false, false);
    pmax = fmaxf(__uint_as_float(rr[0]), __uint_as_float(rr[1])); }
  if (__builtin_expect(__all(pmax - m_reg <= THR / SCALE), 1)) { mn = m_reg; alpha = 1.f; }
  else { mn = fmaxf(m_reg, pmax); alpha = __builtin_amdgcn_exp2f((m_reg - mn) * C); m_reg = mn; }
  float mnC = -mn * C;
  for (int r = 0; r < 16; ++r) p0[r] = fmaf(p0[r], C, mnC); for (int r = 0; r < 16; ++r) p1[r] = fmaf(p1[r], C, mnC);
  for (int r = 0; r < 16; ++r) p0[r] = __builtin_amdgcn_exp2f(p0[r]);
}
__device__ __forceinline__ void finishSM(f32x16& p0, f32x16& p1, float alpha, float& l_reg, bf16x8& pa0, bf16x8& pa1, bf16x8& pa2, bf16x8& pa3) {
  for (int r = 0; r < 16; ++r) p1[r] = __builtin_amdgcn_exp2f(p1[r]);
  float ps = 0; for (int r = 0; r < 16; ++r) ps += p0[r]; for (int r = 0; r < 16; ++r) ps += p1[r];
  { auto rr = __builtin_amdgcn_permlane32_swap(__float_as_uint(ps), __float_as_uint(ps), false, false);
    ps = __uint_as_float(rr[0]) + __uint_as_float(rr[1]); }
  l_reg = l_reg * alpha + ps;
#define PK4(P, BASE, OUT) do { unsigned a0 = cvtpk(P[BASE + 0], P[BASE + 1]), a1 = cvtpk(P[BASE + 2], P[BASE + 3]);   \
    unsigned b0 = cvtpk(P[BASE + 4], P[BASE + 5]), b1 = cvtpk(P[BASE + 6], P[BASE + 7]);                              \
    auto r0 = __builtin_amdgcn_permlane32_swap(a0, b0, false, false); auto r1 = __builtin_amdgcn_permlane32_swap(a1, b1, false, false); \
    u32x4 w = {r0[0], r1[0], r0[1], r1[1]}; OUT = *reinterpret_cast<bf16x8*>(&w); } while (0)
  PK4(p0, 0, pa0); PK4(p0, 8, pa1); PK4(p1, 0, pa2); PK4(p1, 8, pa3);
#undef PK4
}
__device__ __forceinline__ void qkt(f32x16& p0, f32x16& p1, const bf16* Ks, const bf16x8* qr, int r32, int hi) {
  p0 = f32x16{}; p1 = f32x16{};
  for (int d0 = 0; d0 < 8; ++d0) { int cb = (d0 * 16 + hi * 8) * 2;
    bf16x8 b0 = *reinterpret_cast<const bf16x8*>((const char*)Ks + KSWZ(r32, cb));
    bf16x8 b1 = *reinterpret_cast<const bf16x8*>((const char*)Ks + KSWZ(32 + r32, cb));
    p0 = __builtin_amdgcn_mfma_f32_32x32x16_bf16(b0, qr[d0], p0, 0, 0, 0);
    p1 = __builtin_amdgcn_mfma_f32_32x32x16_bf16(b1, qr[d0], p1, 0, 0, 0); }
}
__device__ __forceinline__ int v_st(int k, int c) { const int kk = (k & ~0xC) | ((k & 4) << 1) | ((k & 8) >> 1); return ((kk >> 3) * 4 + (c >> 5)) * 512 + ((kk & 7) * 32 + (c & 31)) * 2; }
__device__ __forceinline__ int v_rd_base(int lane) { return ((lane & 3) << 3) | (((lane >> 2) & 3) << 6) | (((lane >> 4) & 1) << 5) | (((lane >> 5) & 1) << 8); }
constexpr int v_rd_off(int d0, int ks, int half) { return d0 * 512 + ks * 4096 + half * 2048; }
template <int OFF> __device__ __forceinline__ s16x4 tr_read(int vb) {
  s16x4 r; asm volatile("ds_read_b64_tr_b16 %0, %1 offset:%2" : "=&v"(r) : "v"(vb), "i"(OFF) : "memory"); return r;
}
template <int D0> __device__ __forceinline__ void pv_one(f32x16& od, int vb, bf16x8 pa0, bf16x8 pa1, bf16x8 pa2, bf16x8 pa3) {
  const s16x4 l0 = tr_read<v_rd_off(D0, 0, 0)>(vb), h0 = tr_read<v_rd_off(D0, 0, 1)>(vb), l1 = tr_read<v_rd_off(D0, 1, 0)>(vb), h1 = tr_read<v_rd_off(D0, 1, 1)>(vb);
  const s16x4 l2 = tr_read<v_rd_off(D0, 2, 0)>(vb), h2 = tr_read<v_rd_off(D0, 2, 1)>(vb), l3 = tr_read<v_rd_off(D0, 3, 0)>(vb), h3 = tr_read<v_rd_off(D0, 3, 1)>(vb);
  asm volatile("s_waitcnt lgkmcnt(0)" ::: "memory"); SBAR();
#define PK(L, H) (bf16x8){L[0], L[1], L[2], L[3], H[0], H[1], H[2], H[3]}
  od = __builtin_amdgcn_mfma_f32_32x32x16_bf16(pa0, PK(l0, h0), od, 0, 0, 0);
  od = __builtin_amdgcn_mfma_f32_32x32x16_bf16(pa1, PK(l1, h1), od, 0, 0, 0);
  od = __builtin_amdgcn_mfma_f32_32x32x16_bf16(pa2, PK(l2, h2), od, 0, 0, 0);
  od = __builtin_amdgcn_mfma_f32_32x32x16_bf16(pa3, PK(l3, h3), od, 0, 0, 0);
#undef PK
}
__device__ __forceinline__ void pv_d0(f32x16* o, int vb, bf16x8 pa0, bf16x8 pa1, bf16x8 pa2, bf16x8 pa3) {
  pv_one<0>(o[0], vb, pa0, pa1, pa2, pa3); pv_one<1>(o[1], vb, pa0, pa1, pa2, pa3); pv_one<2>(o[2], vb, pa0, pa1, pa2, pa3); pv_one<3>(o[3], vb, pa0, pa1, pa2, pa3);
}

template <typename TQ>
__device__ __forceinline__ void attn_dense_body(const TQ* __restrict__ Qb, const bf16* __restrict__ Kh, const bf16* __restrict__ Vh,
                                                unsigned short* __restrict__ Ob, int seq, char* lds) {
  using St = Stage<bf16>; using SQ = Stage<TQ>;
  const int tid = threadIdx.x, wid = tid >> 6, lane = tid & 63, r32 = lane & 31, hi = lane >> 5;
  bf16* V_lds = (bf16*)lds; bf16* K_lds = (bf16*)(lds + 2 * SHM_V);
  float* ws = (float*)(lds + 2 * SHM_V + 2 * SHM_K) + wid * 64; float* li_l = ws; float* al_l = ws + 32;
  float m_reg = -1e30f, l_reg = 0; f32x16 o[4] = {}; bf16x8 qr[8];
  const TQ* Qw = Qb + (long)(wid * QBLK + r32) * LDQ + hi * 8;
#pragma unroll
  for (int d0 = 0; d0 < 8; ++d0) qr[d0] = SQ::tobf(SQ::ld8(Qw + d0 * 16));
  const int sr = tid >> 4, sc = (tid & 15) * 8, vst0 = v_st(sr, sc), vst1 = v_st(32 + sr, sc);
  const int vb0 = (int)(uintptr_t)V_lds + v_rd_base(lane);
  struct { typename St::T vs0, vs1, ks0, ks1; } sr_[SDEPTH];
#define SLOAD(i, k0) do { sr_[i].vs0 = St::ld8(&Vh[(long)((k0) + sr) * LDK + sc]); sr_[i].vs1 = St::ld8(&Vh[(long)((k0) + 32 + sr) * LDK + sc]); \
    sr_[i].ks0 = St::ld8(&Kh[(long)((k0) + sr) * LDK + sc]); sr_[i].ks1 = St::ld8(&Kh[(long)((k0) + 32 + sr) * LDK + sc]); } while (0)
#define SWRITE(b, i) do { *(bf16x8*)((char*)V_lds + (b) * SHM_V + vst0) = St::tobf(sr_[i].vs0);          \
    *(bf16x8*)((char*)V_lds + (b) * SHM_V + vst1) = St::tobf(sr_[i].vs1); int kc = sc * 2;               \
    *(bf16x8*)((char*)K_lds + (b) * SHM_K + KSWZ(sr, kc)) = St::tobf(sr_[i].ks0);                       \
    *(bf16x8*)((char*)K_lds + (b) * SHM_K + KSWZ(32 + sr, kc)) = St::tobf(sr_[i].ks1); } while (0)
#define SWAIT() do { if constexpr (SDEPTH == 2) asm volatile("s_waitcnt vmcnt(4)" ::: "memory"); else asm volatile("s_waitcnt vmcnt(0)" ::: "memory"); } while (0)
#define RESC(a) do { if (__any((a) < 1.f)) { if (hi == 0) al_l[r32] = (a); asm volatile("s_waitcnt lgkmcnt(0)" ::: "memory"); \
    for (int d = 0; d < 4; ++d) for (int r = 0; r < 16; ++r) o[d][r] *= al_l[crow(r, hi)]; } } while (0)
  f32x16 pA0, pA1, pB0, pB1; float mnA, mnB, alA, alB; bf16x8 pa0, pa1, pa2, pa3; const int NT = seq / KVBLK;
  constexpr int SE = 0, SO = SDEPTH - 1;
  SLOAD(SE, 0); asm volatile("s_waitcnt vmcnt(0)" ::: "memory"); SWRITE(0, SE); __syncthreads();
  qkt(pA0, pA1, K_lds, qr, r32, hi); partialSM(pA0, pA1, m_reg, mnA, alA);
  SLOAD(SO, KVBLK); if constexpr (SDEPTH == 2) { if (2 < NT) SLOAD(SE, 2 * KVBLK); }
  SWAIT(); SWRITE(1, SO); __syncthreads();
  for (int j = 1; j + 1 < NT; j += 2) {
    SBAR(); qkt(pB0, pB1, (bf16*)((char*)K_lds + SHM_K), qr, r32, hi);
    finishSM(pA0, pA1, alA, l_reg, pa0, pa1, pa2, pa3); SBAR();
    SLOAD(SO, (j + SDEPTH) * KVBLK); SBAR();
    pv_d0(o, vb0, pa0, pa1, pa2, pa3); partialSM(pB0, pB1, m_reg, mnB, alB);
    __syncthreads(); SWAIT(); SWRITE(0, SE);
    RESC(alB); __syncthreads();
    SBAR(); qkt(pA0, pA1, K_lds, qr, r32, hi);
    finishSM(pB0, pB1, alB, l_reg, pa0, pa1, pa2, pa3); SBAR();
    if (SDEPTH == 1 || j + 3 < NT) SLOAD(SE, (j + 1 + SDEPTH) * KVBLK); SBAR();
    pv_d0(o, vb0 + (int)SHM_V, pa0, pa1, pa2, pa3); partialSM(pA0, pA1, m_reg, mnA, alA);
    __syncthreads(); SWAIT(); SWRITE(1, SO);
    RESC(alA); __syncthreads();
  }
  SBAR(); qkt(pB0, pB1, (bf16*)((char*)K_lds + SHM_K), qr, r32, hi);
  finishSM(pA0, pA1, alA, l_reg, pa0, pa1, pa2, pa3); SBAR();
  pv_d0(o, vb0, pa0, pa1, pa2, pa3); partialSM(pB0, pB1, m_reg, mnB, alB);
  __syncthreads(); RESC(alB);
  finishSM(pB0, pB1, alB, l_reg, pa0, pa1, pa2, pa3); SBAR();
  pv_d0(o, vb0 + (int)SHM_V, pa0, pa1, pa2, pa3);
  if (hi == 0) li_l[r32] = l_reg; asm volatile("s_waitcnt lgkmcnt(0)" ::: "memory");
  float rli[16];
#pragma unroll
  for (int r = 0; r < 16; ++r) rli[r] = __builtin_amdgcn_rcpf(li_l[crow(r, hi)]);
  unsigned short* Ow = Ob + (long)(wid * QBLK) * LDO;
#pragma unroll
  for (int r = 0; r < 16; ++r) { int orow = crow(r, hi);
    for (int d0 = 0; d0 < 4; ++d0) Ow[(long)orow * LDO + d0 * 32 + r32] = f2bf_att(o[d0][r] * rli[r]); }
#undef SLOAD
#undef SWRITE
#undef SWAIT
#undef RESC
}
}

#define MFMA16(a, b, c) __builtin_amdgcn_mfma_f32_16x16x32_bf16((a), (b), (c), 0, 0, 0)

__device__ __forceinline__ bf16x8_t tr_frag(const void* base, int rs, int k0, int n0, int lane) {
  const int g = lane >> 4, qq = (lane & 15) >> 2, pp = lane & 3;
  const unsigned a0 = (unsigned)(uintptr_t)base + (unsigned)((k0 + 8 * g + qq) * rs + (n0 + 4 * pp) * 2);
  const unsigned a1 = a0 + 4u * (unsigned)rs;
  s16x4_t lo, hi;
  asm volatile("ds_read_b64_tr_b16 %0, %2\n\tds_read_b64_tr_b16 %1, %3\n\ts_waitcnt lgkmcnt(0)" : "=&v"(lo), "=&v"(hi) : "v"(a0), "v"(a1) : "memory");
  return (bf16x8_t){lo[0], lo[1], lo[2], lo[3], hi[0], hi[1], hi[2], hi[3]};
}

struct WJob { const float* src; int ld, col0, K, N, Npad; bf16_t* dst; };
__device__ __forceinline__ WJob get_wjob(const Params& p, int j) {
  unsigned char* ws = p.ws; WJob w;
  if (j < 4)       { w.src = p.in[7] + (size_t)j * DM * DFF; w.ld = DFF; w.col0 = 0; w.K = DM; w.N = DFF; w.Npad = DFF; w.dst = (bf16_t*)(ws + WT_W1) + (size_t)j * DM * DFF; }
  else if (j < 8)  { w.src = p.in[8] + (size_t)(j - 4) * DM * DFF; w.ld = DM; w.col0 = 0; w.K = DFF; w.N = DM; w.Npad = DM; w.dst = (bf16_t*)(ws + WT_W2) + (size_t)(j - 4) * DM * DFF; }
  else if (j == 8) { w.src = p.in[9]; w.ld = 1536; w.col0 = 0; w.K = DM; w.N = 1536; w.Npad = 1536; w.dst = (bf16_t*)(ws + WT_GQKV); }
  else if (j == 9) { w.src = p.in[12]; w.ld = DM; w.col0 = 0; w.K = DM; w.N = DM; w.Npad = DM; w.dst = (bf16_t*)(ws + WT_GO); }
  else if (j == 10){ w.src = p.in[21]; w.ld = DM; w.col0 = 0; w.K = DM; w.N = DM; w.Npad = DM; w.dst = (bf16_t*)(ws + WT_GLU); }
  else if (j == 11){ w.src = p.in[23]; w.ld = 5184; w.col0 = 2048; w.K = DM; w.N = 3136; w.Npad = SSD_N1; w.dst = (bf16_t*)(ws + WT_SIN1); }
  else if (j == 12){ w.src = p.in[23]; w.ld = 5184; w.col0 = 0; w.K = DM; w.N = 2048; w.Npad = 2048; w.dst = (bf16_t*)(ws + WT_SGATE); }
  else if (j == 13){ w.src = p.in[30]; w.ld = DM; w.col0 = 0; w.K = 2048; w.N = DM; w.Npad = DM; w.dst = (bf16_t*)(ws + WT_SOUT); }
  else if (j == 14){ w.src = p.in[31]; w.ld = 3072; w.col0 = 0; w.K = DM; w.N = 3072; w.Npad = 3072; w.dst = (bf16_t*)(ws + WT_NQKV); }
  else             { w.src = p.in[33]; w.ld = DM; w.col0 = 0; w.K = DM; w.N = DM; w.Npad = DM; w.dst = (bf16_t*)(ws + WT_NO); }
  return w;
}

__device__ __forceinline__ void phase_prep(const Params& p, unsigned char* lds) {
  const int tid = threadIdx.x, lane = tid & 63, wid = tid >> 6;
  float* tile = (float*)lds;
  for (int j = 0; j < 16; ++j) {
    const WJob w = get_wjob(p, j);
    const int tn = w.Npad / 64, tk = w.K / 64, nt = tn * tk;
    for (int t = blockIdx.x; t < nt; t += gridDim.x) {
      const int n0 = (t % tn) * 64, k0 = (t / tn) * 64;
      const bool valid = n0 < w.N;
      if (valid) {
#pragma unroll
        for (int it = 0; it < 2; ++it) { const int kk = it * 32 + (tid >> 4), nn = (tid & 15) * 4;
          const float4 v = *(const float4*)(w.src + (size_t)(k0 + kk) * w.ld + w.col0 + n0 + nn);
          tile[kk * 65 + nn + 0] = v.x; tile[kk * 65 + nn + 1] = v.y; tile[kk * 65 + nn + 2] = v.z; tile[kk * 65 + nn + 3] = v.w; }
      }
      __syncthreads();
      { const int nn = tid >> 3, kk8 = (tid & 7) * 8; float f[8];
#pragma unroll
        for (int q = 0; q < 8; ++q) f[q] = valid ? tile[(kk8 + q) * 65 + nn] : 0.f;
        *(uint4*)(w.dst + (size_t)(n0 + nn) * w.K + k0 + kk8) = pack8(f); }
      __syncthreads();
    }
  }
  float* sc = (float*)lds;
  float* red = sc + 9 * 1024;
  const float* c = p.in[1]; const float* cc = p.in[3]; const float* ada_w = p.in[4]; const float* ada_b = p.in[5];
  float* MOD = (float*)(p.ws + WS_MOD);
  __syncthreads();
  for (int i = tid; i < 9 * 1024; i += 512) { const float v = (i < 8192) ? c[i] : cc[i - 8192]; sc[i] = v / (1.0f + expf(-v)); }
  __syncthreads();
  for (int t = blockIdx.x; t < 384; t += gridDim.x) {
    const int l = t / 96, n0 = (t % 96) * 64;
    const float* W = ada_w + (size_t)l * DM * 6144 + n0 + lane;
    float acc[9];
#pragma unroll
    for (int b = 0; b < 9; ++b) acc[b] = 0.f;
    const int kb = wid * 128;
#pragma unroll 8
    for (int k = kb; k < kb + 128; ++k) { const float wv = W[(size_t)k * 6144];
#pragma unroll
      for (int b = 0; b < 9; ++b) acc[b] += sc[b * 1024 + k] * wv; }
#pragma unroll
    for (int b = 0; b < 9; ++b) red[(wid * 9 + b) * 64 + lane] = acc[b];
    __syncthreads();
    for (int i = tid; i < 9 * 64; i += 512) { const int b = i >> 6, ln = i & 63; float s = 0.f;
#pragma unroll
      for (int w8 = 0; w8 < 8; ++w8) s += red[(w8 * 9 + b) * 64 + ln];
      MOD[((size_t)l * 9 + b) * 6144 + n0 + ln] = s + ada_b[(size_t)l * 6144 + n0 + ln]; }
    __syncthreads();
  }
  {
    const float* a_re = p.in[13]; const float* a_im = p.in[14]; const float* log_dt = p.in[15]; const float* b_re = p.in[16]; const float* b_im = p.in[17];
    float2* ABAR = (float2*)(p.ws + WS_S5A); float2* AT = ABAR + 8192; float2* BBAR = AT + 8192;
    for (int idx = blockIdx.x * 512 + tid; idx < 8192; idx += gridDim.x * 512) {
      const int dg = idx >> 6;
      const double lr = (double)a_re[idx], li = (double)a_im[idx], dt = exp((double)log_dt[dg]);
      const double er = exp(lr * dt), ar = er * cos(li * dt), ai = er * sin(li * dt);
      const double e64 = exp(lr * dt * 64.0), tr = e64 * cos(li * dt * 64.0), ti = e64 * sin(li * dt * 64.0);
      ABAR[idx] = make_float2((float)ar, (float)ai); AT[idx] = make_float2((float)tr, (float)ti);
      const double nr = ar - 1.0, ni = ai, den = lr * lr + li * li;
      const double cr = (nr * lr + ni * li) / den, ci = (ni * lr - nr * li) / den;
      for (int cch = 0; cch < 16; ++cch) { const double br = (double)b_re[(size_t)idx * 16 + cch], bi = (double)b_im[(size_t)idx * 16 + cch];
        BBAR[(size_t)idx * 16 + cch] = make_float2((float)(cr * br - ci * bi), (float)(cr * bi + ci * br)); }
    }
  }
}

struct RowArgs { const bf16_t* Y; int g_post, m_gate; int do_norm, g_pre, m_shift, m_scale; int init, skip_ctx; };
__device__ __forceinline__ void phase_row(const Params& p, const RowArgs a) {
  const int tid = threadIdx.x, lane = tid & 63, wid = tid >> 6;
  const float* NG = p.in[6]; const float* MOD = (const float*)(p.ws + WS_MOD);
  float* XC = (float*)(p.ws + WS_XC); bf16_t* H = (bf16_t*)(p.ws + WS_H);
  const int gw = blockIdx.x * 8 + wid, nw = gridDim.x * 8;
  for (int row = gw; row < MR; row += nw) {
    const int b = row / TT, t = row - b * TT;
    const bool isctx = t < CTXL;
    if (isctx && a.skip_ctx) continue;
    const int b9 = isctx ? 8 : b;
    float* xp = isctx ? XC + ((size_t)b * CTXL + t) * DM : p.out + ((size_t)b * SEQ + (t - CTXL)) * DM;
    const float* xin = a.init ? (isctx ? p.in[2] + ((size_t)b * CTXL + t) * DM : p.in[0] + ((size_t)b * SEQ + (t - CTXL)) * DM) : xp;
    float x[16];
#pragma unroll
    for (int j = 0; j < 4; ++j) { const float4 v = *(const float4*)(xin + j * 256 + lane * 4); x[4 * j] = v.x; x[4 * j + 1] = v.y; x[4 * j + 2] = v.z; x[4 * j + 3] = v.w; }
    if (a.Y) {
      float y[16]; float ss = 0.f;
#pragma unroll
      for (int j = 0; j < 4; ++j) { const uint2 v = *(const uint2*)(a.Y + (size_t)row * DM + j * 256 + lane * 4);
        y[4 * j] = __uint_as_float(v.x << 16); y[4 * j + 1] = __uint_as_float(v.x & 0xffff0000u); y[4 * j + 2] = __uint_as_float(v.y << 16); y[4 * j + 3] = __uint_as_float(v.y & 0xffff0000u); }
#pragma unroll
      for (int e = 0; e < 16; ++e) ss += y[e] * y[e];
      ss = wave_sum(ss); const float rs = rsqrtf(ss * (1.0f / DM) + EPS);
      const float* gp = NG + (size_t)a.g_post * DM; const float* gate = MOD + ((size_t)(a.m_gate / 6) * 9 + b9) * 6144 + (a.m_gate % 6) * DM;
#pragma unroll
      for (int j = 0; j < 4; ++j) { const float4 gv = *(const float4*)(gp + j * 256 + lane * 4); const float4 tv = *(const float4*)(gate + j * 256 + lane * 4);
        x[4 * j] += tv.x * (y[4 * j] * rs * gv.x); x[4 * j + 1] += tv.y * (y[4 * j + 1] * rs * gv.y); x[4 * j + 2] += tv.z * (y[4 * j + 2] * rs * gv.z); x[4 * j + 3] += tv.w * (y[4 * j + 3] * rs * gv.w); }
    }
    if (a.Y || a.init) {
#pragma unroll
      for (int j = 0; j < 4; ++j) *(float4*)(xp + j * 256 + lane * 4) = make_float4(x[4 * j], x[4 * j + 1], x[4 * j + 2], x[4 * j + 3]);
    }
    if (a.do_norm) {
      float ss = 0.f;
#pragma unroll
      for (int e = 0; e < 16; ++e) ss += x[e] * x[e];
      ss = wave_sum(ss); const float rs = rsqrtf(ss * (1.0f / DM) + EPS);
      const float* gp = NG + (size_t)a.g_pre * DM;
      const float* sh = MOD + ((size_t)(a.m_shift / 6) * 9 + b9) * 6144 + (a.m_shift % 6) * DM;
      const float* scl = MOD + ((size_t)(a.m_scale / 6) * 9 + b9) * 6144 + (a.m_scale % 6) * DM;
#pragma unroll
      for (int j = 0; j < 4; ++j) { const float4 gv = *(const float4*)(gp + j * 256 + lane * 4); const float4 sv = *(const float4*)(sh + j * 256 + lane * 4); const float4 cv = *(const float4*)(scl + j * 256 + lane * 4);
        const float h0 = x[4 * j] * rs * gv.x * (1.0f + cv.x) + sv.x, h1 = x[4 * j + 1] * rs * gv.y * (1.0f + cv.y) + sv.y;
        const float h2 = x[4 * j + 2] * rs * gv.z * (1.0f + cv.z) + sv.z, h3 = x[4 * j + 3] * rs * gv.w * (1.0f + cv.w) + sv.w;
        uint2 o; o.x = pk2(h0, h1); o.y = pk2(h2, h3);
        *(uint2*)(H + (size_t)row * DM + j * 256 + lane * 4) = o; }
    }
  }
}

template <int ACT>
__device__ __forceinline__ void phase_gemm(unsigned char* lds, const bf16_t* A, const bf16_t* Bt, int N, int K, bf16_t* O, int ldc, const float* bias, const bf16_t* aux) {
  pg8::Gemm g{A, Bt, MR, N, K}; pg8::StaticOrder S; S.init(MR, N, (int)gridDim.x, (int)blockIdx.x);
  pg8::EpiB<ACT> E{O, ldc, bias, aux};
  pg8::gemm_phase<pg8::EpiB<ACT>, pg8::StaticOrder, false>((PG8_LAS unsigned char*)lds, g, S, E, nullptr);
  __syncthreads();
}

__device__ __forceinline__ void phase_gqa_qknorm(const Params& p, bf16_t* QKV) {
  const int tid = threadIdx.x, lane = tid & 63, wid = tid >> 6;
  const float* qn = p.in[10]; const float* kn = p.in[11];
  const int gw = blockIdx.x * 8 + wid, nw = gridDim.x * 8;
  const int hf = lane >> 5, i = lane & 31, d1 = hf * 64 + i, d2 = d1 + 32;
  const float inv = exp2f(-(float)i * (13.287712379549449f / 32.0f));
  for (int item = gw; item < MR * 10; item += nw) {
    const int row = item / 10, hd = item - row * 10; const int t = row % TT;
    bf16_t* ptr = QKV + (size_t)row * 1536 + (hd < 8 ? hd * 128 : 1024 + (hd - 8) * 128);
    const float* g = hd < 8 ? qn : kn;
    float x1 = bf2f(ptr[d1]), x2 = bf2f(ptr[d2]);
    const float ss = wave_sum(x1 * x1 + x2 * x2); const float rs = rsqrtf(ss * (1.0f / 128.0f) + EPS);
    x1 *= rs * g[d1]; x2 *= rs * g[d2];
    if (t >= CTXL) { const int tl = t - CTXL; const float pos = hf ? (float)(tl & 63) : (float)(tl >> 6);
      float sn, cs; sincosf(pos * inv, &sn, &cs);
      const float o1 = x1 * cs - x2 * sn, o2 = x1 * sn + x2 * cs; x1 = o1; x2 = o2; }
    ptr[d1] = f2bf(x1); ptr[d2] = f2bf(x2);
  }
}

__device__ __forceinline__ void phase_gqa_attn(unsigned char* lds, const bf16_t* QKV, bf16_t* Ob) {
  for (int u = blockIdx.x; u < 576; u += gridDim.x) {
    const bf16_t *Q, *K; bf16_t* O; int seq;
    if (u < 512) { const int b = u >> 6, h = (u >> 3) & 7, qb = u & 7;
      Q = QKV + ((size_t)b * TT + CTXL + qb * 256) * 1536 + h * 128; K = QKV + (size_t)b * TT * 1536 + 1024 + (h >> 2) * 128;
      O = Ob + ((size_t)b * TT + CTXL + qb * 256) * DM + h * 128; seq = TT; }
    else { const int uu = u - 512, b = uu >> 3, h = uu & 7;
      Q = QKV + (size_t)b * TT * 1536 + h * 128; K = QKV + (size_t)b * TT * 1536 + 1024 + (h >> 2) * 128;
      O = Ob + (size_t)b * TT * DM + h * 128; seq = CTXL; }
    att::attn_dense_body<att::bf16>(Q, K, K + 256, O, seq, (char*)lds);
    __syncthreads();
  }
}

__device__ __forceinline__ int s5_seqidx(int k, int dir) { return dir == 0 ? k : (k < 4 ? 3 - k : 39 - k); }

__device__ __forceinline__ void s5_stage_u(const bf16_t* H, float* ub, int b, int g, int k, int lane) {
  const uint4* src = (const uint4*)(H + ((size_t)b * TT + k * 64 + lane) * DM + g * 16);
  const uint4 v0 = src[0], v1 = src[1]; float f[16]; unpack8(v0, f); unpack8(v1, f + 8);
#pragma unroll
  for (int q = 0; q < 4; ++q) *(float4*)(ub + lane * 16 + q * 4) = make_float4(f[4 * q], f[4 * q + 1], f[4 * q + 2], f[4 * q + 3]);
}

__device__ __forceinline__ void phase_s5_local(const Params& p, unsigned char* lds, float2* SLOC) {
  const int tid = threadIdx.x, lane = tid & 63, wid = tid >> 6;
  const bf16_t* H = (const bf16_t*)(p.ws + WS_H);
  const float2* ABAR = (const float2*)(p.ws + WS_S5A); const float2* BBAR = ABAR + 16384;
  float* ub = (float*)lds + wid * 1024;
  const int gw = blockIdx.x * 8 + wid, nw = gridDim.x * 8;
  for (int item = gw; item < NB * 64 * 2 * 36; item += nw) {
    const int k = item % 36; int r = item / 36; const int dir = r & 1; r >>= 1; const int g = r & 63, b = r >> 6;
    const int dgp = (dir * 64 + g) * 64 + lane;
    const float2 a = ABAR[dgp];
    float br[16], bi[16];
#pragma unroll
    for (int c = 0; c < 16; ++c) { const float2 v = BBAR[(size_t)dgp * 16 + c]; br[c] = v.x; bi[c] = v.y; }
    s5_stage_u(H, ub, b, g, k, lane);
    asm volatile("s_waitcnt lgkmcnt(0)" ::: "memory");
    float sr = 0.f, si = 0.f;
    for (int s = 0; s < 64; ++s) {
      const int l = dir ? 63 - s : s;
      float u[16];
#pragma unroll
      for (int q = 0; q < 4; ++q) { const float4 v = *(const float4*)(ub + l * 16 + q * 4); u[4 * q] = v.x; u[4 * q + 1] = v.y; u[4 * q + 2] = v.z; u[4 * q + 3] = v.w; }
      float xr = 0.f, xi = 0.f;
#pragma unroll
      for (int c = 0; c < 16; ++c) { xr += br[c] * u[c]; xi += bi[c] * u[c]; }
      const float nr = a.x * sr - a.y * si + xr, ni = a.x * si + a.y * sr + xi; sr = nr; si = ni;
    }
    SLOC[((size_t)((b * 64 + g) * 2 + dir) * 36 + s5_seqidx(k, dir)) * 64 + lane] = make_float2(sr, si);
    asm volatile("s_waitcnt lgkmcnt(0)" ::: "memory");
  }
}

__device__ __forceinline__ void phase_s5_carry(const Params& p, const float2* SLOC, float2* SIN) {
  const float2* AT = (const float2*)(p.ws + WS_S5A) + 8192;
  for (int idx = blockIdx.x * 512 + threadIdx.x; idx < NB * 64 * 2 * 64; idx += gridDim.x * 512) {
    const int pp = idx & 63, bgd = idx >> 6; const int dir = bgd & 1, g = (bgd >> 1) & 63;
    const float2 a = AT[(dir * 64 + g) * 64 + pp];
    float sr = 0.f, si = 0.f;
    for (int kk = 0; kk < 36; ++kk) { const size_t o = ((size_t)bgd * 36 + kk) * 64 + pp;
      SIN[o] = make_float2(sr, si); const float2 l = SLOC[o];
      const float nr = a.x * sr - a.y * si + l.x, ni = a.x * si + a.y * sr + l.y; sr = nr; si = ni; }
  }
}

__device__ __forceinline__ void phase_s5_full(const Params& p, unsigned char* lds, const float2* SIN, bf16_t* G) {
  const int tid = threadIdx.x, lane = tid & 63, wid = tid >> 6;
  const bf16_t* H = (const bf16_t*)(p.ws + WS_H);
  const float2* ABAR = (const float2*)(p.ws + WS_S5A); const float2* BBAR = ABAR + 16384;
  const float* c_re = p.in[18]; const float* c_im = p.in[19]; const float* dsk = p.in[20];
  float* ub = (float*)lds + wid * 2048;
  float* yb = ub + 1024;
  const int gw = blockIdx.x * 8 + wid, nw = gridDim.x * 8;
  const bool b5 = lane & 32, b4 = lane & 16, b3 = lane & 8, b2 = lane & 4;
  const int cown = lane >> 2;
  for (int item = gw; item < NB * 64 * 36; item += nw) {
    const int k = item % 36; int r = item / 36; const int g = r & 63, b = r >> 6;
    s5_stage_u(H, ub, b, g, k, lane);
    asm volatile("s_waitcnt lgkmcnt(0)" ::: "memory");
    for (int dir = 0; dir < 2; ++dir) {
      const int dgp = (dir * 64 + g) * 64 + lane;
      const float2 a = ABAR[dgp];
      float br[16], bi[16], cr[16], ci[16];
#pragma unroll
      for (int c = 0; c < 16; ++c) { const float2 v = BBAR[(size_t)dgp * 16 + c]; br[c] = v.x; bi[c] = v.y;
        cr[c] = c_re[((size_t)(dir * 64 + g) * 16 + c) * 64 + lane]; ci[c] = c_im[((size_t)(dir * 64 + g) * 16 + c) * 64 + lane]; }
      const float2 s0 = SIN[((size_t)((b * 64 + g) * 2 + dir) * 36 + s5_seqidx(k, dir)) * 64 + lane];
      float sr = s0.x, si = s0.y;
      for (int s = 0; s < 64; ++s) {
        const int l = dir ? 63 - s : s;
        float u[16];
#pragma unroll
        for (int q = 0; q < 4; ++q) { const float4 v = *(const float4*)(ub + l * 16 + q * 4); u[4 * q] = v.x; u[4 * q + 1] = v.y; u[4 * q + 2] = v.z; u[4 * q + 3] = v.w; }
        float xr = 0.f, xi = 0.f;
#pragma unroll
        for (int c = 0; c < 16; ++c) { xr += br[c] * u[c]; xi += bi[c] * u[c]; }
        const float nr = a.x * sr - a.y * si + xr, ni = a.x * si + a.y * sr + xi; sr = nr; si = ni;
        float v[16];
#pragma unroll
        for (int c = 0; c < 16; ++c) v[c] = cr[c] * sr - ci[c] * si;
        float w8[8];
#pragma unroll
        for (int j = 0; j < 8; ++j) { const float keep = b5 ? v[8 + j] : v[j], send = b5 ? v[j] : v[8 + j]; w8[j] = keep + __shfl_xor(send, 32); }
        float w4[4];
#pragma unroll
        for (int j = 0; j < 4; ++j) { const float keep = b4 ? w8[4 + j] : w8[j], send = b4 ? w8[j] : w8[4 + j]; w4[j] = keep + __shfl_xor(send, 16); }
        float w2[2];
#pragma unroll
        for (int j = 0; j < 2; ++j) { const float keep = b3 ? w4[2 + j] : w4[j], send = b3 ? w4[j] : w4[2 + j]; w2[j] = keep + __shfl_xor(send, 8); }
        float z; { const float keep = b2 ? w2[1] : w2[0], send = b2 ? w2[0] : w2[1]; z = keep + __shfl_xor(send, 4); }
        z += __shfl_xor(z, 1); z += __shfl_xor(z, 2);
        if ((lane & 3) == 0) { if (dir == 0) yb[l * 16 + cown] = z; else yb[l * 16 + cown] += z; }
      }
      asm volatile("s_waitcnt lgkmcnt(0)" ::: "memory");
    }
    { float o[16];
#pragma unroll
      for (int c = 0; c < 16; ++c) { const float zz = ub[lane * 16 + c] * dsk[g * 16 + c] + yb[lane * 16 + c];
        const float t3 = 0.7978845608028654f * (zz + 0.044715f * zz * zz * zz); o[c] = 0.5f * zz * (1.0f + tanhf(t3)); }
      uint4* dst = (uint4*)(G + ((size_t)b * TT + k * 64 + lane) * DM + g * 16);
      dst[0] = pack8(o); dst[1] = pack8(o + 8); }
    asm volatile("s_waitcnt lgkmcnt(0)" ::: "memory");
  }
}

__device__ __forceinline__ void phase_ssd_conv(const Params& p, const bf16_t* P1, bf16_t* XBC) {
  const float* cw = p.in[24]; const float* cb = p.in[25]; const float* dtb = p.in[26];
  float* DT = (float*)(p.ws + WS_DT);
  const size_t gt = (size_t)blockIdx.x * 512 + threadIdx.x, nthr = (size_t)gridDim.x * 512;
  for (size_t idx = gt; idx < (size_t)MR * 384; idx += nthr) {
    const int row = (int)(idx / 384), cg8 = (int)(idx % 384) * 8; const int t = row % TT;
    const int lo = t < CTXL ? 0 : CTXL, hi = t < CTXL ? CTXL : TT;
    float acc[8];
    { const float4 b0 = *(const float4*)(cb + cg8), b1 = *(const float4*)(cb + cg8 + 4); acc[0] = b0.x; acc[1] = b0.y; acc[2] = b0.z; acc[3] = b0.w; acc[4] = b1.x; acc[5] = b1.y; acc[6] = b1.z; acc[7] = b1.w; }
#pragma unroll
    for (int k = 0; k < 5; ++k) { const int tt = t + k - 2;
      if (tt >= lo && tt < hi) { const uint4 v = *(const uint4*)(P1 + (size_t)(row + k - 2) * SSD_N1 + cg8); float f[8]; unpack8(v, f);
        const float4 w0 = *(const float4*)(cw + k * 3072 + cg8), w1 = *(const float4*)(cw + k * 3072 + cg8 + 4);
        acc[0] += w0.x * f[0]; acc[1] += w0.y * f[1]; acc[2] += w0.z * f[2]; acc[3] += w0.w * f[3]; acc[4] += w1.x * f[4]; acc[5] += w1.y * f[5]; acc[6] += w1.z * f[6]; acc[7] += w1.w * f[7]; } }
#pragma unroll
    for (int q = 0; q < 8; ++q) acc[q] = silu_f(acc[q]);
    *(uint4*)(XBC + (size_t)row * 3072 + cg8) = pack8(acc);
  }
  for (size_t idx = gt; idx < (size_t)MR * 64; idx += nthr) {
    const int row = (int)(idx >> 6), j = (int)(idx & 63);
    const float v = bf2f(P1[(size_t)row * SSD_N1 + 3072 + j]) + dtb[j];
    DT[idx] = v > 20.f ? v : log1pf(expf(v));
  }
}

__device__ __forceinline__ void phase_ssd_scan(const Params& p, unsigned char* lds, const bf16_t* XBC, bf16_t* YS) {
  const int tid = threadIdx.x, lane = tid & 63, wid = tid >> 6, fr = lane & 15, fq = lane >> 4;
  const float* DT = (const float*)(p.ws + WS_DT); const float* a_log = p.in[27]; const float* dskip = p.in[28];
  bf16_t* Cs = (bf16_t*)lds;
  bf16_t* Bs = Cs + 64 * 136;
  bf16_t* Sb = Bs + 64 * 136;
  bf16_t* Xd = Sb + 64 * 136;
  bf16_t* Xw = Xd + 64 * 72;
  bf16_t* Xr = Xw + 64 * 72;
  bf16_t* Ps = Xr + 64 * 72;
  float* cum = (float*)(Ps + 64 * 72);
  float* dts = cum + 64;
  float* tot = dts + 64;
  for (int item = blockIdx.x; item < NB * 32; item += gridDim.x) {
    const int b = item >> 5, h = item & 31, gr = h >> 3;
    const float dsk = dskip[h];
    for (int dir = 0; dir < 2; ++dir) {
      const float a = -expf(a_log[dir * 32 + h]);
      f32x4_t S[4];
#pragma unroll
      for (int q = 0; q < 4; ++q) S[q] = (f32x4_t){0.f, 0.f, 0.f, 0.f};
      __syncthreads();
      for (int i = tid; i < 64 * 136 / 2; i += 512) ((unsigned*)Sb)[i] = 0u;
      for (int kk = 0; kk < 36; ++kk) {
        const int k = s5_seqidx(kk, dir);
        const size_t row0 = (size_t)b * TT + k * 64;
        __syncthreads();
        if (wid == 0) {
          const float dtv = DT[(row0 + lane) * 64 + dir * 32 + h]; float c = dtv * a;
          if (dir == 0) {
#pragma unroll
            for (int o = 1; o < 64; o <<= 1) { const float t = __shfl_up(c, o); if (lane >= o) c += t; } }
          else {
#pragma unroll
            for (int o = 1; o < 64; o <<= 1) { const float t = __shfl_down(c, o); if (lane + o < 64) c += t; } }
          cum[lane] = c; dts[lane] = dtv;
          if (dir == 0 ? lane == 63 : lane == 0) tot[0] = c;
        }
        __syncthreads();
#pragma unroll
        for (int it = 0; it < 2; ++it) { const int idx = tid + it * 512, l = idx >> 4, c8 = (idx & 15) * 8;
          const uint4 vb = *(const uint4*)(XBC + (row0 + l) * 3072 + 2048 + gr * 128 + c8);
          const uint4 vc = *(const uint4*)(XBC + (row0 + l) * 3072 + 2560 + gr * 128 + c8);
          *(uint4*)(Bs + l * 136 + c8) = vb; *(uint4*)(Cs + l * 136 + c8) = vc; }
        { const int l = tid >> 3, c8 = (tid & 7) * 8; const uint4 vx = *(const uint4*)(XBC + (row0 + l) * 3072 + h * 64 + c8);
          const float dtl = dts[l], wl = __expf(tot[0] - cum[l]); float f[8], fw[8]; unpack8(vx, f);
#pragma unroll
          for (int q = 0; q < 8; ++q) { f[q] *= dtl; fw[q] = f[q] * wl; }
          *(uint4*)(Xr + l * 72 + c8) = vx; *(uint4*)(Xd + l * 72 + c8) = pack8(f); *(uint4*)(Xw + l * 72 + c8) = pack8(fw); }
        __syncthreads();
        { const int lt = wid >> 1;
#pragma unroll
          for (int s2 = 0; s2 < 2; ++s2) { const int st = (wid & 1) * 2 + s2; f32x4_t g = (f32x4_t){0.f, 0.f, 0.f, 0.f};
#pragma unroll
            for (int ks = 0; ks < 4; ++ks) { const bf16x8_t af = *(const bf16x8_t*)(Cs + (16 * lt + fr) * 136 + 32 * ks + 8 * fq);
              const bf16x8_t bfr = *(const bf16x8_t*)(Bs + (16 * st + fr) * 136 + 32 * ks + 8 * fq); g = MFMA16(af, bfr, g); }
#pragma unroll
            for (int r = 0; r < 4; ++r) { const int l = 16 * lt + 4 * fq + r, s = 16 * st + fr; const bool ok = dir == 0 ? s <= l : s >= l;
              const float v = ok ? g[r] * __expf(cum[l] - cum[s]) : 0.f; Ps[l * 72 + s] = f2bf(v); } } }
        __syncthreads();
        { const int lt = wid >> 1;
#pragma unroll
          for (int p2 = 0; p2 < 2; ++p2) { const int pt = (wid & 1) * 2 + p2; f32x4_t y1 = (f32x4_t){0.f, 0.f, 0.f, 0.f}, y2 = y1;
#pragma unroll
            for (int ks = 0; ks < 2; ++ks) { const bf16x8_t af = *(const bf16x8_t*)(Ps + (16 * lt + fr) * 72 + 32 * ks + 8 * fq);
              const bf16x8_t bfr = tr_frag(Xd, 144, 32 * ks, 16 * pt, lane); y1 = MFMA16(af, bfr, y1); }
#pragma unroll
            for (int ks = 0; ks < 4; ++ks) { const bf16x8_t af = *(const bf16x8_t*)(Cs + (16 * lt + fr) * 136 + 32 * ks + 8 * fq);
              const bf16x8_t bfr = *(const bf16x8_t*)(Sb + (16 * pt + fr) * 136 + 32 * ks + 8 * fq); y2 = MFMA16(af, bfr, y2); }
#pragma unroll
            for (int r = 0; r < 4; ++r) { const int l = 16 * lt + 4 * fq + r, pp = 16 * pt + fr; float y = y1[r] + __expf(cum[l]) * y2[r];
              const size_t oi = (row0 + l) * 2048 + h * 64 + pp;
              if (dir == 0) y += dsk * bf2f(Xr[l * 72 + pp]); else y += bf2f(YS[oi]);
              YS[oi] = f2bf(y); } } }
        __syncthreads();
        { const float et = __expf(tot[0]); bf16x8_t bfr[2];
#pragma unroll
          for (int ks = 0; ks < 2; ++ks) bfr[ks] = tr_frag(Bs, 272, 32 * ks, 16 * wid, lane);
#pragma unroll
          for (int pt = 0; pt < 4; ++pt) { f32x4_t acc = S[pt] * et;
#pragma unroll
            for (int ks = 0; ks < 2; ++ks) { const bf16x8_t af = tr_frag(Xw, 144, 32 * ks, 16 * pt, lane); acc = MFMA16(af, bfr[ks], acc); }
            S[pt] = acc;
#pragma unroll
            for (int r = 0; r < 4; ++r) Sb[(16 * pt + 4 * fq + r) * 136 + 16 * wid + fr] = f2bf(acc[r]); } }
      }
    }
  }
  __syncthreads();
}

__device__ __forceinline__ void phase_ssd_gate(const Params& p, bf16_t* YS, const bf16_t* GATE) {
  const int tid = threadIdx.x, lane = tid & 63, wid = tid >> 6; const float* ng = p.in[29];
  const int gw = blockIdx.x * 8 + wid, nw = gridDim.x * 8;
  for (int item = gw; item < MR * 4; item += nw) {
    const size_t off = (size_t)(item >> 2) * 2048 + (item & 3) * 512 + lane * 8;
    float y[8], g[8]; unpack8(*(const uint4*)(YS + off), y); unpack8(*(const uint4*)(GATE + off), g);
    float ss = 0.f;
#pragma unroll
    for (int q = 0; q < 8; ++q) { y[q] *= silu_f(g[q]); ss += y[q] * y[q]; }
    ss = wave_sum(ss); const float rs = rsqrtf(ss * (1.0f / 512.0f) + EPS);
    const float* gp = ng + (item & 3) * 512 + lane * 8;
#pragma unroll
    for (int q = 0; q < 8; ++q) y[q] *= rs * gp[q];
    *(uint4*)(YS + off) = pack8(y);
  }
}

__device__ __forceinline__ void phase_na_attn(const Params& p, unsigned char* lds, const bf16_t* QKV, bf16_t* Ob) {
  const int tid = threadIdx.x, lane = tid & 63, wid = tid >> 6, fr = lane & 15, fq = lane >> 4;
  const float* rpb = p.in[32];
  float* mbuf = (float*)lds;
  float* lbuf = mbuf + 128;
  float* obuf = lbuf + 128;
  const int wq = wid & 3; const bool isctx = wid >= 4;
  const int c0 = 16 * wq, qcol = c0 + fr, cbase = min(max(c0 - 8, 0), 32), cs = min(max(qcol - 8, 0), 48);
  for (int item = blockIdx.x; item < NB * 16 * 32; item += gridDim.x) {
    const int b = item >> 9, hh = (item >> 5) & 15, r = item & 31;
    const int r0 = min(max(r - 4, 0), 24);
    const size_t brow = (size_t)b * TT;
    const size_t qrow = brow + CTXL + r * 64 + qcol;
    bf16x8_t qf[2];
#pragma unroll
    for (int ks = 0; ks < 2; ++ks) qf[ks] = *(const bf16x8_t*)(QKV + qrow * 3072 + hh * 64 + 32 * ks + 8 * fq);
    f32x4_t s[16];
    float mx = -INFINITY;
#pragma unroll
    for (int tile = 0; tile < 16; ++tile) {
      const int i = tile >> 1, jh = tile & 1;
      const size_t krow = isctx ? brow + tile * 16 + fr : brow + CTXL + (r0 + i) * 64 + cbase + 16 * jh + fr;
      f32x4_t acc = (f32x4_t){0.f, 0.f, 0.f, 0.f};
#pragma unroll
      for (int ks = 0; ks < 2; ++ks) { const bf16x8_t kf = *(const bf16x8_t*)(QKV + krow * 3072 + 1024 + hh * 64 + 32 * ks + 8 * fq); acc = MFMA16(kf, qf[ks], acc); }
#pragma unroll
      for (int rg = 0; rg < 4; ++rg) { float v = acc[rg] * 0.125f;
        if (!isctx) { const int kcol = cbase + 16 * jh + 4 * fq + rg; const bool ok = kcol >= cs && kcol < cs + 16;
          const int rr = r0 + i - r + 7, crl = min(max(kcol - qcol + 15, 0), 30);
          const float bias = rpb[hh * 465 + rr * 31 + crl]; v = ok ? v + bias : -INFINITY; }
        acc[rg] = v; mx = fmaxf(mx, v); }
      s[tile] = acc;
    }
    mx = fmaxf(mx, __shfl_xor(mx, 16)); mx = fmaxf(mx, __shfl_xor(mx, 32));
    if (fq == 0) mbuf[wid * 16 + fr] = mx;
    __syncthreads();
    const float Mx = fmaxf(mbuf[wq * 16 + fr], mbuf[(wq + 4) * 16 + fr]);
    float ls = 0.f;
#pragma unroll
    for (int tile = 0; tile < 16; ++tile)
#pragma unroll
      for (int rg = 0; rg < 4; ++rg) { const float e = __expf(s[tile][rg] - Mx); s[tile][rg] = e; ls += e; }
    ls += __shfl_xor(ls, 16); ls += __shfl_xor(ls, 32);
    if (fq == 0) lbuf[wid * 16 + fr] = ls;
    f32x4_t o[4];
#pragma unroll
    for (int dt = 0; dt < 4; ++dt) o[dt] = (f32x4_t){0.f, 0.f, 0.f, 0.f};
#pragma unroll
    for (int ks8 = 0; ks8 < 8; ++ks8) {
      bf16x8_t pf;
      { const f32x4_t pa = s[2 * ks8], pb = s[2 * ks8 + 1];
        pf[0] = (short)f2bf(pa[0]); pf[1] = (short)f2bf(pa[1]); pf[2] = (short)f2bf(pa[2]); pf[3] = (short)f2bf(pa[3]);
        pf[4] = (short)f2bf(pb[0]); pf[5] = (short)f2bf(pb[1]); pf[6] = (short)f2bf(pb[2]); pf[7] = (short)f2bf(pb[3]); }
      const size_t ka = isctx ? brow + (2 * ks8) * 16 + 4 * fq : brow + CTXL + (r0 + ks8) * 64 + cbase + 4 * fq;
      const size_t kb = ka + 16;
#pragma unroll
      for (int dt = 0; dt < 4; ++dt) { bf16x8_t vf; const bf16_t* vp = QKV + 2048 + hh * 64 + 16 * dt + fr;
#pragma unroll
        for (int j = 0; j < 4; ++j) { vf[j] = (short)vp[(ka + j) * 3072]; vf[4 + j] = (short)vp[(kb + j) * 3072]; }
        o[dt] = MFMA16(pf, vf, o[dt]); }
    }
    if (isctx) {
#pragma unroll
      for (int dt = 0; dt < 4; ++dt)
#pragma unroll
        for (int rg = 0; rg < 4; ++rg) obuf[(wq * 16 + 4 * fq + rg) * 64 + 16 * dt + fr] = o[dt][rg];
    }
    __syncthreads();
    if (!isctx) {
#pragma unroll
      for (int rg = 0; rg < 4; ++rg) { const int qi = 4 * fq + rg; const float lt = lbuf[wq * 16 + qi] + lbuf[(wq + 4) * 16 + qi]; const float il = 1.0f / lt;
        bf16_t* op = Ob + (brow + CTXL + r * 64 + c0 + qi) * DM + hh * 64;
#pragma unroll
        for (int dt = 0; dt < 4; ++dt) op[16 * dt + fr] = f2bf((o[dt][rg] + obuf[(wq * 16 + qi) * 64 + 16 * dt + fr]) * il); }
    }
  }
  __syncthreads();
}

constexpr int NPHASE = 35;
__global__ void __launch_bounds__(512, 2) mega_fwd(Params p) {
  extern __shared__ __attribute__((aligned(16))) unsigned char lds[];
  cg::grid_group grid = cg::this_grid();
  unsigned char* ws = p.ws;
  bf16_t* H = (bf16_t*)(ws + WS_H);
  unsigned char* BIG = ws + WS_BIG;
  int ph = 0;
#define PHASE(body) do { if (ph >= p.ph_lo && ph < p.ph_hi) { body; if (ph + 1 < p.ph_hi) grid.sync(); } ++ph; } while (0)
#define ROWARGS(Y, gpost, mgate, donorm, gpre, msh, msc, init, skipc) (RowArgs{(Y), (gpost), (mgate), (donorm), (gpre), (msh), (msc), (init), (skipc)})
#define MLP(L, LAST) do { \
    PHASE((phase_gemm<1>(lds, H, (const bf16_t*)(ws + WT_W1) + (size_t)(L) * DM * DFF, DFF, DM, (bf16_t*)BIG, DFF, nullptr, nullptr))); \
    PHASE((phase_gemm<0>(lds, (const bf16_t*)BIG, (const bf16_t*)(ws + WT_W2) + (size_t)(L) * DM * DFF, DM, DFF, (bf16_t*)(BIG + 144 * MiB), DM, nullptr, nullptr))); \
    PHASE((phase_row(p, ROWARGS((const bf16_t*)(BIG + 144 * MiB), (L) * 4 + 3, (L) * 6 + 5, (LAST) ? 0 : 1, ((L) + 1) * 4 + 0, ((L) + 1) * 6 + 0, ((L) + 1) * 6 + 1, 0, (LAST) ? 1 : 0)))); \
  } while (0)

  PHASE(phase_prep(p, lds));
  PHASE(phase_row(p, ROWARGS(nullptr, 0, 0, 1, 0, 0, 1, 1, 0)));
  { bf16_t* QKV = (bf16_t*)BIG; bf16_t* O = (bf16_t*)(BIG + 56 * MiB); bf16_t* Y = (bf16_t*)(BIG + 96 * MiB);
    PHASE((phase_gemm<0>(lds, H, (const bf16_t*)(ws + WT_GQKV), 1536, DM, QKV, 1536, nullptr, nullptr)));
    PHASE(phase_gqa_qknorm(p, QKV));
    PHASE(phase_gqa_attn(lds, QKV, O));
    PHASE((phase_gemm<0>(lds, O, (const bf16_t*)(ws + WT_GO), DM, DM, Y, DM, nullptr, nullptr)));
    PHASE(phase_row(p, ROWARGS(Y, 0 * 4 + 1, 0 * 6 + 2, 1, 0 * 4 + 2, 0 * 6 + 3, 0 * 6 + 4, 0, 0)));
    MLP(0, 0); }
  { bf16_t* G = (bf16_t*)BIG; bf16_t* Y = (bf16_t*)(BIG + 40 * MiB); float2* SLOC = (float2*)(BIG + 80 * MiB); float2* SIN = (float2*)(BIG + 100 * MiB);
    PHASE(phase_s5_local(p, lds, SLOC));
    PHASE(phase_s5_carry(p, SLOC, SIN));
    PHASE(phase_s5_full(p, lds, SIN, G));
    PHASE((phase_gemm<2>(lds, G, (const bf16_t*)(ws + WT_GLU), DM, DM, Y, DM, p.in[22], G)));
    PHASE(phase_row(p, ROWARGS(Y, 1 * 4 + 1, 1 * 6 + 2, 1, 1 * 4 + 2, 1 * 6 + 3, 1 * 6 + 4, 0, 0)));
    MLP(1, 0); }
  { bf16_t* P1 = (bf16_t*)BIG; bf16_t* XBC = (bf16_t*)(BIG + 117 * MiB); bf16_t* YS = (bf16_t*)BIG; bf16_t* Y = (bf16_t*)(BIG + 72 * MiB); bf16_t* GATE = (bf16_t*)(BIG + 117 * MiB);
    PHASE((phase_gemm<0>(lds, H, (const bf16_t*)(ws + WT_SIN1), SSD_N1, DM, P1, SSD_N1, nullptr, nullptr)));
    PHASE(phase_ssd_conv(p, P1, XBC));
    PHASE(phase_ssd_scan(p, lds, XBC, YS));
    PHASE((phase_gemm<0>(lds, H, (const bf16_t*)(ws + WT_SGATE), 2048, DM, GATE, 2048, nullptr, nullptr)));
    PHASE(phase_ssd_gate(p, YS, GATE));
    PHASE((phase_gemm<0>(lds, YS, (const bf16_t*)(ws + WT_SOUT), DM, 2048, Y, DM, nullptr, nullptr)));
    PHASE(phase_row(p, ROWARGS(Y, 2 * 4 + 1, 2 * 6 + 2, 1, 2 * 4 + 2, 2 * 6 + 3, 2 * 6 + 4, 0, 0)));
    MLP(2, 0); }
  { bf16_t* QKV = (bf16_t*)BIG; bf16_t* O = (bf16_t*)(BIG + 108 * MiB); bf16_t* Y = (bf16_t*)(BIG + 144 * MiB);
    PHASE((phase_gemm<0>(lds, H, (const bf16_t*)(ws + WT_NQKV), 3072, DM, QKV, 3072, nullptr, nullptr)));
    PHASE(phase_na_attn(p, lds, QKV, O));
    PHASE((phase_gemm<0>(lds, O, (const bf16_t*)(ws + WT_NO), DM, DM, Y, DM, nullptr, nullptr)));
    PHASE(phase_row(p, ROWARGS(Y, 3 * 4 + 1, 3 * 6 + 2, 1, 3 * 4 + 2, 3 * 6 + 3, 3 * 6 + 4, 0, 1)));
    MLP(3, 1); }
}

constexpr int LDS_BYTES = 131072;
extern "C" void kernel_launch(void* const* d_in, const int* in_sizes, int n_in, void* d_out, int out_size, void* d_ws, size_t ws_size, hipStream_t stream) {
  static int grid = 0;
  if (grid == 0) {
    if (n_in != 34 || ws_size < WS_END || out_size != NB * SEQ * DM) { fprintf(stderr, "kernel_launch: unexpected shapes (n_in %d, ws %zu need %zu, out %d)\n", n_in, ws_size, (size_t)WS_END, out_size); grid = -1; return; }
    int dev = 0, cus = 0, per_cu = 0;
    hipGetDevice(&dev); hipDeviceGetAttribute(&cus, hipDeviceAttributeMultiprocessorCount, dev);
    if (hipFuncSetAttribute((const void*)mega_fwd, hipFuncAttributeMaxDynamicSharedMemorySize, LDS_BYTES) != hipSuccess) { fprintf(stderr, "kernel_launch: hipFuncSetAttribute failed\n"); grid = -1; return; }
    if (hipOccupancyMaxActiveBlocksPerMultiprocessor(&per_cu, (const void*)mega_fwd, 512, LDS_BYTES) != hipSuccess || per_cu < 1) { fprintf(stderr, "kernel_launch: occupancy query says %d\n", per_cu); grid = -1; return; }
    grid = cus;
  }
  if (grid < 0) return;
  Params p{};
  for (int i = 0; i < 34; ++i) p.in[i] = (const float*)d_in[i];
  p.out = (float*)d_out; p.ws = (unsigned char*)d_ws;
#if MK_MULTI
  for (int ph = 0; ph < NPHASE; ++ph) { p.ph_lo = ph; p.ph_hi = ph + 1; hipLaunchKernelGGL(mega_fwd, dim3(grid), dim3(512), LDS_BYTES, stream, p); }
#else
  p.ph_lo = 0; p.ph_hi = NPHASE;
  void* args[] = {&p};
  hipError_t e = hipLaunchCooperativeKernel((const void*)mega_fwd, dim3(grid), dim3(512), args, LDS_BYTES, stream);
  if (e != hipSuccess) fprintf(stderr, "cooperative launch failed: %s (grid %d)\n", hipGetErrorString(e), grid);
#endif
}
```

```cpp
#include <hip/hip_runtime.h>
#include <hip/hip_cooperative_groups.h>
#include <cstdio>
#include <cstdint>
namespace cg = cooperative_groups;

#ifndef MK_MULTI
#define MK_MULTI 0
#define MK_DUPMASK 0ull
#endif

typedef unsigned short bf16_t;
typedef short bf16x8_t __attribute__((ext_vector_type(8)));
typedef short s16x4_t __attribute__((ext_vector_type(4)));
typedef float f32x4_t __attribute__((ext_vector_type(4)));
typedef unsigned u32x4_t __attribute__((ext_vector_type(4)));
typedef _Float16 h16x4_t __attribute__((ext_vector_type(4)));

constexpr int DM = 1024, NB = 8, SEQ = 2048, CTXL = 256, TT = 2304, MR = NB * TT, DFF = 4096;
constexpr float EPS = 1e-6f;
constexpr size_t MiB = 1024ull * 1024ull;
constexpr size_t WS_XC = 0;
constexpr size_t WS_MOD = 8 * MiB;
constexpr size_t WS_S5A = 9 * MiB;
constexpr size_t WS_BAR = 10 * MiB + 512 * 1024;
constexpr size_t WS_DT = 11 * MiB;
constexpr size_t WS_WT = 16 * MiB;
constexpr size_t WT_W1 = WS_WT;
constexpr size_t WT_W2 = WT_W1 + 32 * MiB;
constexpr size_t WT_GQKV = WT_W2 + 32 * MiB;
constexpr size_t WT_GO = WT_GQKV + 3 * MiB;
constexpr size_t WT_GLU = WT_GO + 2 * MiB;
constexpr size_t WT_SIN1 = WT_GLU + 2 * MiB;
constexpr size_t WT_SGATE = WT_SIN1 + 13 * MiB / 2;
constexpr size_t WT_SOUT = WT_SGATE + 4 * MiB;
constexpr size_t WT_NQKV = WT_SOUT + 4 * MiB;
constexpr size_t WT_NO = WT_NQKV + 6 * MiB;
constexpr size_t WS_XB = WT_NO + 2 * MiB;
constexpr size_t WS_H = WS_XB;
constexpr size_t WS_BIG = WS_H + 36 * MiB;
constexpr size_t WS_S5T = WS_BIG + 225 * MiB;
constexpr size_t WS_END = WS_S5T + 9 * MiB;
constexpr int SSD_N1 = 3328;

__device__ __forceinline__ float bf2f(bf16_t v) { return __uint_as_float(((unsigned)v) << 16); }
__device__ __forceinline__ unsigned pk2(float lo, float hi);
__device__ __forceinline__ bf16_t f2bf(float f) { return (bf16_t)(pk2(f, f) & 0xffffu); }
__device__ __forceinline__ unsigned short f2bf_att(float f) { return f2bf(f); }
typedef __bf16 bf16v2_t __attribute__((ext_vector_type(2)));
typedef float f32v2_t __attribute__((ext_vector_type(2)));
__device__ __forceinline__ unsigned pk2(float lo, float hi) { const f32v2_t v = {lo, hi}; const bf16v2_t b = __builtin_convertvector(v, bf16v2_t); return __builtin_bit_cast(unsigned, b); }
__device__ __forceinline__ float wave_sum(float v) {
#pragma unroll
  for (int o = 32; o >= 1; o >>= 1) v += __shfl_xor(v, o);
  return v;
}
__device__ __forceinline__ void unpack8(uint4 v, float* f) {
  f[0] = __uint_as_float(v.x << 16); f[1] = __uint_as_float(v.x & 0xffff0000u);
  f[2] = __uint_as_float(v.y << 16); f[3] = __uint_as_float(v.y & 0xffff0000u);
  f[4] = __uint_as_float(v.z << 16); f[5] = __uint_as_float(v.z & 0xffff0000u);
  f[6] = __uint_as_float(v.w << 16); f[7] = __uint_as_float(v.w & 0xffff0000u);
}
__device__ __forceinline__ uint4 pack8(const float* f) {
  uint4 v; v.x = pk2(f[0], f[1]); v.y = pk2(f[2], f[3]); v.z = pk2(f[4], f[5]); v.w = pk2(f[6], f[7]); return v;
}
__device__ __forceinline__ float frcp(float x) { return __builtin_amdgcn_rcpf(x); }
__device__ __forceinline__ float silu_f(float x) { return x * frcp(1.0f + __expf(-x)); }

struct Params {
  const float* in[34];
  float* out;
  unsigned char* ws;
  int ph_lo, ph_hi;
};
namespace pg8 {
#define PG8_LAS __attribute__((address_space(3)))
typedef unsigned short bf16_t;
typedef short bf16x8 __attribute__((ext_vector_type(8)));
typedef float f32x4 __attribute__((ext_vector_type(4)));
typedef unsigned u32x4 __attribute__((ext_vector_type(4)));
constexpr int BM = 256, BK = 64, HALF = 128, HTB = HALF * BK * 2  , STAGE_BYTES = 8 * HTB, NXCD = 8, WGM = 8;

__host__ __device__ __forceinline__ int lds_byte(int r, int c) { const int st = (r >> 4) * 2 + (c >> 5), rr = r & 15, cc = c & 31, ob = rr * 64 + cc * 2; return st * 1024 + (ob ^ (((ob >> 9) & 1) << 5)); }
__host__ __device__ __forceinline__ void stage_rc(int b, int& R, int& C) { const int st = b / 1024, sb = b % 1024, swz = sb ^ (((sb >> 9) & 1) << 5); R = (st >> 1) * 16 + swz / 64; C = (st & 1) * 32 + (swz % 64) / 2; }
__host__ __device__ __forceinline__ int perm32(int rho) { const int n = rho >> 4, i = rho & 15; return 8 * (i >> 2) + 4 * n + (i & 3); }

struct Unit { int pm, pn; size_t ao, bo; };
struct Gemm { const bf16_t* A; const bf16_t* Bt; int M, N, K, lda, ldb; };

struct StaticOrder {
    int nM, nN, nwg, G, c, lda, ldb;
    __host__ __device__ void init(int M, int N, int G_, int c_, int lda_, int ldb_) { nM = M / BM; nN = N / BM; nwg = nM * nN; G = G_; c = c_; lda = lda_; ldb = ldb_; }
    __host__ __device__ bool next(int i, Unit& u) const {
        const long L = (long)i * G + c; if (L >= nwg) return false;
        int wgid = (int)L; { const int q = nwg / NXCD, r = nwg % NXCD, xcd = wgid % NXCD, off = wgid / NXCD; wgid = (xcd < r ? xcd * (q + 1) : r * (q + 1) + (xcd - r) * q) + off; }
        const int nig = WGM * nN, gid = wgid / nig, fm = gid * WGM, gsz = (nM - fm) < WGM ? (nM - fm) : WGM;
        u.pm = fm + ((wgid % nig) % gsz); u.pn = (wgid % nig) / gsz; u.ao = (size_t)u.pm * BM * lda * 2; u.bo = (size_t)u.pn * BM * ldb * 2; return true;
    }
    __device__ __forceinline__ void a_ready(const Unit&) const {}
    __device__ __forceinline__ void done(const Unit&) const {}
};

struct LatOrder {
    int nN, G, c, lda, ldb;
    __device__ void init(int N, int G_, int c_, int lda_, int ldb_) { nN = N / BM; G = G_; c = c_; lda = lda_; ldb = ldb_; }
    __device__ bool next(int i, Unit& u) const {
        const int x = c & 7, q = i * (G >> 3) + (c >> 3); if (q >= 8 * nN) return false;
        const int rt = x * 8 + (q & 7); u.pn = q >> 3; u.pm = (rt >> 3) * 9 + 1 + (rt & 7);
        u.ao = (size_t)u.pm * BM * lda * 2; u.bo = (size_t)u.pn * BM * ldb * 2; return true;
    }
    __device__ __forceinline__ void a_ready(const Unit&) const {}
    __device__ __forceinline__ void done(const Unit&) const {}
};
struct CtxSplitOrder {
    int nN, KS, Kp, G, c, lda, ldb;
    __device__ void init(int N, int KS_, int Kp_, int G_, int c_, int lda_, int ldb_) { nN = N / BM; KS = KS_; Kp = Kp_; G = G_; c = c_; lda = lda_; ldb = ldb_; }
    __device__ bool next(int i, Unit& u) const {
        if (i > 0) return false;
        const int x = c & 7, j = c >> 3, ks = x % KS, idx = (x / KS) * (G >> 3) + j; if (idx >= 8 * nN) return false;
        const int b = idx & 7, pn = idx >> 3;
        u.pm = b; u.pn = ks * nN + pn;
        u.ao = ((size_t)(b * 9) * BM * lda + (size_t)ks * Kp) * 2; u.bo = ((size_t)pn * BM * ldb + (size_t)ks * Kp) * 2; return true;
    }
    __device__ __forceinline__ void a_ready(const Unit&) const {}
    __device__ __forceinline__ void done(const Unit&) const {}
};
__device__ __forceinline__ unsigned cvt_pk_bf16(float lo, float hi) { unsigned r; asm volatile("v_cvt_pk_bf16_f32 %0, %1, %2" : "=v"(r) : "v"(lo), "v"(hi)); return r; }
typedef float f32x2 __attribute__((ext_vector_type(2)));
template <int ACT> struct EpiB {
    static constexpr bool PERM = true, AFTER_DRAIN = false;
    bf16_t* O; int ldc; const float* bias; const bf16_t* aux;
    __device__ __forceinline__ void operator()(const f32x4 (&acc)[2][2][4][2], const Unit& u, int wr, int wc, int fr, int fq) const {
        const int row0 = u.pm * BM + wr * 64 + fr; const int col0 = u.pn * BM + wc * 32 + 8 * fq;
#pragma unroll
        for (int ai = 0; ai < 2; ++ai)
#pragma unroll
            for (int m = 0; m < 4; ++m) { const size_t roff = (size_t)(row0 + ai * HALF + m * 16) * ldc + col0;
#pragma unroll
                for (int bj = 0; bj < 2; ++bj) { f32x4 v0 = acc[ai][bj][m][0], v1 = acc[ai][bj][m][1];
                    if (ACT == 1) {
#pragma unroll
                        for (int j = 0; j < 4; ++j) { float a = v0[j] > 0.f ? v0[j] : 0.f; v0[j] = a * a; float b = v1[j] > 0.f ? v1[j] : 0.f; v1[j] = b * b; } }
                    if (ACT == 2) {
                        const f32x4 b0 = *(const f32x4*)(bias + col0 + bj * HALF), b1 = *(const f32x4*)(bias + col0 + bj * HALF + 4);
                        const u32x4 g = *(const u32x4*)(aux + roff + bj * HALF);
                        float gf[8]; gf[0] = __uint_as_float(g.x << 16); gf[1] = __uint_as_float(g.x & 0xffff0000u); gf[2] = __uint_as_float(g.y << 16); gf[3] = __uint_as_float(g.y & 0xffff0000u);
                        gf[4] = __uint_as_float(g.z << 16); gf[5] = __uint_as_float(g.z & 0xffff0000u); gf[6] = __uint_as_float(g.w << 16); gf[7] = __uint_as_float(g.w & 0xffff0000u);
#pragma unroll
                        for (int j = 0; j < 4; ++j) { v0[j] = gf[j] * ::frcp(1.0f + __expf(-(v0[j] + b0[j]))); v1[j] = gf[4 + j] * ::frcp(1.0f + __expf(-(v1[j] + b1[j]))); } }
                    u32x4 w; w.x = ::pk2(v0[0], v0[1]); w.y = ::pk2(v0[2], v0[3]); w.z = ::pk2(v1[0], v1[1]); w.w = ::pk2(v1[2], v1[3]);
                    *(u32x4*)(O + roff + bj * HALF) = w; } }
    }
};
template <class Epi, class Sched, bool STAMP = false>
__device__ __forceinline__ void gemm_phase(PG8_LAS unsigned char* lds, const Gemm g, const Sched& S, const Epi& E, unsigned long long* stamps) {
    const int tid = threadIdx.x, wid = __builtin_amdgcn_readfirstlane(tid >> 6), lane = tid & 63, wr = wid >> 2, wc = wid & 3, fr = lane & 15, fq = lane >> 4;
    const int K = g.K, nt = K / BK;
    int ts_lo = 0, ts_hi = 0, nts = 0; const unsigned long long rt_entry = STAMP ? (unsigned long long)wall_clock64() : 0ull;
#define PG8_STAMP() do { if (STAMP && wid == 0 && nts < 64) { const unsigned long long _c = (unsigned long long)clock64(); \
        ts_lo = (lane == nts) ? (int)(unsigned)_c : ts_lo; ts_hi = (lane == nts) ? (int)(unsigned)(_c >> 32) : ts_hi; ++nts; } } while (0)
    PG8_STAMP();
    unsigned voffA[2], voffB[2];
#pragma unroll
    for (int i = 0; i < 2; ++i) { int R, C; stage_rc(tid * 16 + i * 8192, R, C); const int Rb = Epi::PERM ? ((R & ~31) + perm32(R & 31)) : R;
        voffA[i] = (unsigned)(R * g.lda + C) * 2u; voffB[i] = (unsigned)(Rb * g.ldb + C) * 2u; }
    const size_t kstep = (size_t)(BK * 2);
    const size_t hstepA = (size_t)HALF * g.lda * 2, hstepB = (size_t)HALF * g.ldb * 2;
    const unsigned ldsw = (unsigned)wid * 1024u;
    const int aoff = lds_byte(wr * 64 + fr, fq * 8), boff = lds_byte(wc * 32 + fr, fq * 8);
#define PG8_SA(b, h) (((b) * 2 + (h)) * HTB)
#define PG8_SB(b, h) ((4 + (b) * 2 + (h)) * HTB)
#define PG8_STAGE(bufoff, gbase, voff) do { _Pragma("unroll") for (int _i = 0; _i < 2; ++_i) \
        __builtin_amdgcn_global_load_lds((const unsigned*)((const char*)(gbase) + (voff)[_i]), (PG8_LAS unsigned*)(lds + (bufoff) + ldsw + _i * 8192), 16, 0, 0); } while (0)
#define PG8_LDA(dst, b, h) do { _Pragma("unroll") for (int m = 0; m < 4; ++m) _Pragma("unroll") for (int k = 0; k < 2; ++k) dst[m][k] = *(const PG8_LAS bf16x8*)(lds + PG8_SA(b, h) + aoff + m * 2048 + k * 1024); } while (0)
#define PG8_LDB(dst, b, h) do { _Pragma("unroll") for (int n = 0; n < 2; ++n) _Pragma("unroll") for (int k = 0; k < 2; ++k) dst[n][k] = *(const PG8_LAS bf16x8*)(lds + PG8_SB(b, h) + boff + n * 2048 + k * 1024); } while (0)
#define PG8_MMA(ai, bj, At, Bt) do { __builtin_amdgcn_s_setprio(1); _Pragma("unroll") for (int m = 0; m < 4; ++m) _Pragma("unroll") for (int n = 0; n < 2; ++n) _Pragma("unroll") for (int k = 0; k < 2; ++k) \
        acc[ai][bj][m][n] = __builtin_amdgcn_mfma_f32_16x16x32_bf16(Bt[n][k], At[m][k], acc[ai][bj][m][n], 0, 0, 0); __builtin_amdgcn_s_setprio(0); } while (0)
#define PG8_WAIT_V(n) asm volatile("s_waitcnt vmcnt(" #n ")" ::: "memory")
#define PG8_WAIT_L(n) asm volatile("s_waitcnt lgkmcnt(" #n ")" ::: "memory")
#define PG8_BAR __builtin_amdgcn_s_barrier()
#define PG8_SCHED __builtin_amdgcn_sched_barrier(0)
    Unit cur, nxt; int ui = 0;
    if (!S.next(0, cur)) return;
    f32x4 acc[2][2][4][2];
#pragma unroll
    for (int a = 0; a < 2; ++a)
#pragma unroll
        for (int b = 0; b < 2; ++b)
#pragma unroll
            for (int m = 0; m < 4; ++m)
#pragma unroll
                for (int n = 0; n < 2; ++n) acc[a][b][m][n] = (f32x4){0.f, 0.f, 0.f, 0.f};
    bf16x8 At[4][2], B0[2][2], B1[2][2];
    const char* cA = (const char*)g.A + cur.ao; const char* cB = (const char*)g.Bt + cur.bo;
    S.a_ready(cur);
    PG8_STAGE(PG8_SB(0, 0), cB, voffB); PG8_STAGE(PG8_SA(0, 0), cA, voffA); PG8_STAGE(PG8_SB(0, 1), cB + hstepB, voffB); PG8_STAGE(PG8_SA(0, 1), cA + hstepA, voffA);
    if (wr == 1) PG8_BAR;
    PG8_WAIT_V(4); PG8_BAR;
    PG8_STAGE(PG8_SB(1, 0), cB + kstep, voffB); PG8_STAGE(PG8_SA(1, 0), cA + kstep, voffA); PG8_STAGE(PG8_SB(1, 1), cB + hstepB + kstep, voffB);
    PG8_WAIT_V(6); PG8_BAR;
    PG8_STAMP();
    for (;;) {
        const bool has_next = S.next(ui + 1, nxt);
        const char* nA = has_next ? (const char*)g.A + nxt.ao : cA; const char* nB = has_next ? (const char*)g.Bt + nxt.bo : cB;
        for (int t = 0; t < nt; t += 2) {
            const bool last = (t == nt - 2);
            const char* a1 = cA + (size_t)(t + 1) * kstep;
            const char* a2 = last ? nA : cA + (size_t)(t + 2) * kstep; const char* b2 = last ? nB : cB + (size_t)(t + 2) * kstep;
            const char* a3 = a2 + kstep; const char* b3 = b2 + kstep;
            if (last && has_next) S.a_ready(nxt);
            PG8_LDB(B0, 0, 0); PG8_SCHED; PG8_LDA(At, 0, 0); PG8_STAGE(PG8_SA(1, 1), a1 + hstepA, voffA);
            PG8_WAIT_L(8); PG8_BAR; PG8_WAIT_L(0); PG8_MMA(0, 0, At, B0); PG8_BAR; PG8_SCHED;
            PG8_LDB(B1, 0, 1); PG8_STAGE(PG8_SB(0, 0), b2, voffB);
            PG8_BAR; PG8_WAIT_L(0); PG8_MMA(0, 1, At, B1); PG8_BAR;
            PG8_LDA(At, 0, 1); PG8_STAGE(PG8_SA(0, 0), a2, voffA);
            PG8_BAR; PG8_WAIT_L(0); PG8_MMA(1, 0, At, B0); PG8_BAR; PG8_SCHED;
            PG8_STAGE(PG8_SB(0, 1), b2 + hstepB, voffB);
            PG8_WAIT_V(6); PG8_BAR; PG8_MMA(1, 1, At, B1); PG8_BAR;
            PG8_LDB(B0, 1, 0); PG8_SCHED; PG8_LDA(At, 1, 0); PG8_STAGE(PG8_SA(0, 1), a2 + hstepA, voffA);
            PG8_WAIT_L(8); PG8_BAR; PG8_WAIT_L(0); PG8_MMA(0, 0, At, B0); PG8_BAR; PG8_SCHED;
            PG8_LDB(B1, 1, 1); PG8_STAGE(PG8_SB(1, 0), b3, voffB);
            PG8_BAR; PG8_WAIT_L(0); PG8_MMA(0, 1, At, B1); PG8_BAR;
            PG8_LDA(At, 1, 1); PG8_STAGE(PG8_SA(1, 0), a3, voffA);
            PG8_BAR; PG8_WAIT_L(0); PG8_MMA(1, 0, At, B0); PG8_BAR; PG8_SCHED;
            PG8_STAGE(PG8_SB(1, 1), b3 + hstepB, voffB);
            PG8_WAIT_V(6); PG8_BAR; PG8_MMA(1, 1, At, B1); PG8_BAR;
        }
        PG8_STAMP();
        if constexpr (!Epi::AFTER_DRAIN) { E(acc, cur, wr, wc, fr, fq); S.done(cur); }
        PG8_STAMP();
        if (!has_next) break;
#pragma unroll
        for (int a = 0; a < 2; ++a)
#pragma unroll
            for (int b = 0; b < 2; ++b)
#pragma unroll
                for (int m = 0; m < 4; ++m)
#pragma unroll
                    for (int n = 0; n < 2; ++n) acc[a][b][m][n] = (f32x4){0.f, 0.f, 0.f, 0.f};
        cur = nxt; cA = nA; cB = nB; ++ui;
    }
    PG8_WAIT_V(0);
    if (wr == 0) PG8_BAR;
    PG8_BAR;
    if constexpr (Epi::AFTER_DRAIN) { E.fused(acc, cur, wr, wc, fr, fq, lds, wid, lane); S.done(cur); }
    PG8_STAMP();
    if (STAMP && wid == 0) { stamps[lane] = lane < nts ? (((unsigned long long)(unsigned)ts_hi << 32) | (unsigned)ts_lo) : 0ull;
        if (lane == 62) stamps[62] = rt_entry; if (lane == 63) stamps[63] = (unsigned long long)wall_clock64(); }
#undef PG8_STAMP
#undef PG8_SA
#undef PG8_SB
#undef PG8_STAGE
#undef PG8_LDA
#undef PG8_LDB
#undef PG8_MMA
#undef PG8_WAIT_V
#undef PG8_WAIT_L
#undef PG8_BAR
#undef PG8_SCHED
}
}
namespace att {
using bf16 = unsigned short;
constexpr int   D = 128, NW = 8, QBLK = 32, KVBLK = 64;
constexpr float SCALE = 0.088388347648318440f;
constexpr float THR = 8.f;
constexpr int SDEPTH = 2;
constexpr int LDQ = 1536, LDK = 1536, LDO = 1024;
constexpr size_t SHM_V = KVBLK * D * 2, SHM_K = KVBLK * D * 2, SHM_ATTN = 2 * SHM_V + 2 * SHM_K + NW * 64 * 4;
using bf16x8 = __attribute__((ext_vector_type(8))) short;
using s16x4  = __attribute__((ext_vector_type(4))) short;
using f32x16 = __attribute__((ext_vector_type(16))) float;
using f32x8  = __attribute__((ext_vector_type(8))) float;
using u32x4  = __attribute__((ext_vector_type(4))) unsigned;
#define KSWZ(row, colB) ((row) * 256 + ((colB) ^ (((row) & 7) << 4)))
#define SBAR() __builtin_amdgcn_sched_barrier(0)
__device__ __forceinline__ int crow(int r, int hi) { return (r & 3) + 8 * (r >> 2) + 4 * hi; }
__device__ __forceinline__ unsigned cvtpk(float lo, float hi) {
  unsigned r; asm volatile("v_cvt_pk_bf16_f32 %0, %1, %2" : "=v"(r) : "v"(lo), "v"(hi)); return r;
}
template <typename TIn> struct Stage;
template <> struct Stage<bf16>  { using T = bf16x8;
  __device__ static __forceinline__ T ld8(const bf16* p) { return *reinterpret_cast<const bf16x8*>(p); }
  __device__ static __forceinline__ bf16x8 tobf(T x) { return x; } };
template <> struct Stage<float> { using T = f32x8;
  __device__ static __forceinline__ T ld8(const float* p) { return *reinterpret_cast<const f32x8*>(p); }
  __device__ static __forceinline__ bf16x8 tobf(T x) {
    u32x4 w = {cvtpk(x[0], x[1]), cvtpk(x[2], x[3]), cvtpk(x[4], x[5]), cvtpk(x[6], x[7])}; return *reinterpret_cast<bf16x8*>(&w); } };

__device__ __forceinline__ void partialSM(f32x16& p0, f32x16& p1, float& m_reg, float& mn, float& alpha) {
  constexpr float C = SCALE * 1.4426950408889634f;
  float pmax = p0[0]; for (int r = 1; r < 16; ++r) pmax = fmaxf(pmax, p0[r]); for (int r = 0; r < 16; ++r) pmax = fmaxf(pmax, p1[r]);
  { auto rr = __builtin_amdgcn_permlane32_swap(__float_as_uint(pmax), __float_as_uint(pmax), false, false);
    pmax = fmaxf(__uint_as_float(rr[0]), __uint_as_float(rr[1])); }
  if (__builtin_expect(__all(pmax - m_reg <= THR / SCALE), 1)) { mn = m_reg; alpha = 1.f; }
  else { mn = fmaxf(m_reg, pmax); alpha = __builtin_amdgcn_exp2f((m_reg - mn) * C); m_reg = mn; }
  float mnC = -mn * C;
  for (int r = 0; r < 16; ++r) p0[r] = fmaf(p0[r], C, mnC); for (int r = 0; r < 16; ++r) p1[r] = fmaf(p1[r], C, mnC);
  for (int r = 0; r < 16; ++r) p0[r] = __builtin_amdgcn_exp2f(p0[r]);
}
__device__ __forceinline__ void finishSM(f32x16& p0, f32x16& p1, float alpha, float& l_reg, bf16x8& pa0, bf16x8& pa1, bf16x8& pa2, bf16x8& pa3) {
  for (int r = 0; r < 16; ++r) p1[r] = __builtin_amdgcn_exp2f(p1[r]);
  float ps = 0; for (int r = 0; r < 16; ++r) ps += p0[r]; for (int r = 0; r < 16; ++r) ps += p1[r];
  { auto rr = __builtin_amdgcn_permlane32_swap(__float_as_uint(ps), __float_as_uint(ps), false, false);
    ps = __uint_as_float(rr[0]) + __uint_as_float(rr[1]); }
  l_reg = l_reg * alpha + ps;
#define PK4(P, BASE, OUT) do { unsigned a0 = cvtpk(P[BASE + 0], P[BASE + 1]), a1 = cvtpk(P[BASE + 2], P[BASE + 3]);   \
    unsigned b0 = cvtpk(P[BASE + 4], P[BASE + 5]), b1 = cvtpk(P[BASE + 6], P[BASE + 7]);                              \
    auto r0 = __builtin_amdgcn_permlane32_swap(a0, b0, false, false); auto r1 = __builtin_amdgcn_permlane32_swap(a1, b1, false, false); \
    u32x4 w = {r0[0], r1[0], r0[1], r1[1]}; OUT = *reinterpret_cast<bf16x8*>(&w); } while (0)
  PK4(p0, 0, pa0); PK4(p0, 8, pa1); PK4(p1, 0, pa2); PK4(p1, 8, pa3);
#undef PK4
}
__device__ __forceinline__ void qkt(f32x16& p0, f32x16& p1, const bf16* Ks, const bf16x8* qr, int r32, int hi) {
  p0 = f32x16{}; p1 = f32x16{};
  for (int d0 = 0; d0 < 8; ++d0) { int cb = (d0 * 16 + hi * 8) * 2;
    bf16x8 b0 = *reinterpret_cast<const bf16x8*>((const char*)Ks + KSWZ(r32, cb));
    bf16x8 b1 = *reinterpret_cast<const bf16x8*>((const char*)Ks + KSWZ(32 + r32, cb));
    p0 = __builtin_amdgcn_mfma_f32_32x32x16_bf16(b0, qr[d0], p0, 0, 0, 0);
    p1 = __builtin_amdgcn_mfma_f32_32x32x16_bf16(b1, qr[d0], p1, 0, 0, 0); }
}
__device__ __forceinline__ int v_st(int k, int c) { const int kk = (k & ~0xC) | ((k & 4) << 1) | ((k & 8) >> 1); return ((kk >> 3) * 4 + (c >> 5)) * 512 + ((kk & 7) * 32 + (c & 31)) * 2; }
__device__ __forceinline__ int v_rd_base(int lane) { return ((lane & 3) << 3) | (((lane >> 2) & 3) << 6) | (((lane >> 4) & 1) << 5) | (((lane >> 5) & 1) << 8); }
constexpr int v_rd_off(int d0, int ks, int half) { return d0 * 512 + ks * 4096 + half * 2048; }
template <int OFF> __device__ __forceinline__ s16x4 tr_read(int vb) {
  s16x4 r; asm volatile("ds_read_b64_tr_b16 %0, %1 offset:%2" : "=&v"(r) : "v"(vb), "i"(OFF) : "memory"); return r;
}
template <int D0> __device__ __forceinline__ void pv_one(f32x16& od, int vb, bf16x8 pa0, bf16x8 pa1, bf16x8 pa2, bf16x8 pa3) {
  const s16x4 l0 = tr_read<v_rd_off(D0, 0, 0)>(vb), h0 = tr_read<v_rd_off(D0, 0, 1)>(vb), l1 = tr_read<v_rd_off(D0, 1, 0)>(vb), h1 = tr_read<v_rd_off(D0, 1, 1)>(vb);
  const s16x4 l2 = tr_read<v_rd_off(D0, 2, 0)>(vb), h2 = tr_read<v_rd_off(D0, 2, 1)>(vb), l3 = tr_read<v_rd_off(D0, 3, 0)>(vb), h3 = tr_read<v_rd_off(D0, 3, 1)>(vb);
  asm volatile("s_waitcnt lgkmcnt(0)" ::: "memory"); SBAR();
#define PK(L, H) (bf16x8){L[0], L[1], L[2], L[3], H[0], H[1], H[2], H[3]}
  od = __builtin_amdgcn_mfma_f32_32x32x16_bf16(pa0, PK(l0, h0), od, 0, 0, 0);
  od = __builtin_amdgcn_mfma_f32_32x32x16_bf16(pa1, PK(l1, h1), od, 0, 0, 0);
  od = __builtin_amdgcn_mfma_f32_32x32x16_bf16(pa2, PK(l2, h2), od, 0, 0, 0);
  od = __builtin_amdgcn_mfma_f32_32x32x16_bf16(pa3, PK(l3, h3), od, 0, 0, 0);
#undef PK
}
__device__ __forceinline__ void pv_d0(f32x16* o, int vb, bf16x8 pa0, bf16x8 pa1, bf16x8 pa2, bf16x8 pa3) {
  pv_one<0>(o[0], vb, pa0, pa1, pa2, pa3); pv_one<1>(o[1], vb, pa0, pa1, pa2, pa3); pv_one<2>(o[2], vb, pa0, pa1, pa2, pa3); pv_one<3>(o[3], vb, pa0, pa1, pa2, pa3);
}

template <typename TQ>
__device__ __forceinline__ void attn_dense_body(const TQ* __restrict__ Qb, const bf16* __restrict__ Kh, const bf16* __restrict__ Vh,
                                                unsigned short* __restrict__ Ob, int seq, char* lds) {
  using St = Stage<bf16>; using SQ = Stage<TQ>;
  const int tid = threadIdx.x, wid = tid >> 6, lane = tid & 63, r32 = lane & 31, hi = lane >> 5;
  bf16* V_lds = (bf16*)lds; bf16* K_lds = (bf16*)(lds + 2 * SHM_V);
  float* ws = (float*)(lds + 2 * SHM_V + 2 * SHM_K) + wid * 64; float* li_l = ws; float* al_l = ws + 32;
  float m_reg = -1e30f, l_reg = 0; f32x16 o[4] = {}; bf16x8 qr[8];
  const TQ* Qw = Qb + (long)(wid * QBLK + r32) * LDQ + hi * 8;
#pragma unroll
  for (int d0 = 0; d0 < 8; ++d0) qr[d0] = SQ::tobf(SQ::ld8(Qw + d0 * 16));
  const int sr = tid >> 4, sc = (tid & 15) * 8, vst0 = v_st(sr, sc), vst1 = v_st(32 + sr, sc);
  const int vb0 = (int)(uintptr_t)V_lds + v_rd_base(lane);
  struct { typename St::T vs0, vs1, ks0, ks1; } sr_[SDEPTH];
#define SLOAD(i, k0) do { sr_[i].vs0 = St::ld8(&Vh[(long)((k0) + sr) * LDK + sc]); sr_[i].vs1 = St::ld8(&Vh[(long)((k0) + 32 + sr) * LDK + sc]); \
    sr_[i].ks0 = St::ld8(&Kh[(long)((k0) + sr) * LDK + sc]); sr_[i].ks1 = St::ld8(&Kh[(long)((k0) + 32 + sr) * LDK + sc]); } while (0)
#define SWRITE(b, i) do { *(bf16x8*)((char*)V_lds + (b) * SHM_V + vst0) = St::tobf(sr_[i].vs0);          \
    *(bf16x8*)((char*)V_lds + (b) * SHM_V + vst1) = St::tobf(sr_[i].vs1); int kc = sc * 2;               \
    *(bf16x8*)((char*)K_lds + (b) * SHM_K + KSWZ(sr, kc)) = St::tobf(sr_[i].ks0);                       \
    *(bf16x8*)((char*)K_lds + (b) * SHM_K + KSWZ(32 + sr, kc)) = St::tobf(sr_[i].ks1); } while (0)
#define SWAIT() do { if constexpr (SDEPTH == 2) asm volatile("s_waitcnt vmcnt(4)" ::: "memory"); else asm volatile("s_waitcnt vmcnt(0)" ::: "memory"); } while (0)
#define RESC(a) do { if (__any((a) < 1.f)) { if (hi == 0) al_l[r32] = (a); asm volatile("s_waitcnt lgkmcnt(0)" ::: "memory"); \
    for (int d = 0; d < 4; ++d) for (int r = 0; r < 16; ++r) o[d][r] *= al_l[crow(r, hi)]; } } while (0)
  f32x16 pA0, pA1, pB0, pB1; float mnA, mnB, alA, alB; bf16x8 pa0, pa1, pa2, pa3; const int NT = seq / KVBLK;
  constexpr int SE = 0, SO = SDEPTH - 1;
  SLOAD(SE, 0); asm volatile("s_waitcnt vmcnt(0)" ::: "memory"); SWRITE(0, SE); __syncthreads();
  qkt(pA0, pA1, K_lds, qr, r32, hi); partialSM(pA0, pA1, m_reg, mnA, alA);
  SLOAD(SO, KVBLK); if constexpr (SDEPTH == 2) { if (2 < NT) SLOAD(SE, 2 * KVBLK); }
  SWAIT(); SWRITE(1, SO); __syncthreads();
  for (int j = 1; j + 1 < NT; j += 2) {
    SBAR(); qkt(pB0, pB1, (bf16*)((char*)K_lds + SHM_K), qr, r32, hi);
    finishSM(pA0, pA1, alA, l_reg, pa0, pa1, pa2, pa3); SBAR();
    SLOAD(SO, (j + SDEPTH) * KVBLK); SBAR();
    pv_d0(o, vb0, pa0, pa1, pa2, pa3); partialSM(pB0, pB1, m_reg, mnB, alB);
    __syncthreads(); SWAIT(); SWRITE(0, SE);
    RESC(alB); __syncthreads();
    SBAR(); qkt(pA0, pA1, K_lds, qr, r32, hi);
    finishSM(pB0, pB1, alB, l_reg, pa0, pa1, pa2, pa3); SBAR();
    if (SDEPTH == 1 || j + 3 < NT) SLOAD(SE, (j + 1 + SDEPTH) * KVBLK); SBAR();
    pv_d0(o, vb0 + (int)SHM_V, pa0, pa1, pa2, pa3); partialSM(pA0, pA1, m_reg, mnA, alA);
    __syncthreads(); SWAIT(); SWRITE(1, SO);
    RESC(alA); __syncthreads();
  }
  SBAR(); qkt(pB0, pB1, (bf16*)((char*)K_lds + SHM_K), qr, r32, hi);
  finishSM(pA0, pA1, alA, l_reg, pa0, pa1, pa2, pa3); SBAR();
  pv_d0(o, vb0, pa0, pa1, pa2, pa3); partialSM(pB0, pB1, m_reg, mnB, alB);
  __syncthreads(); RESC(alB);
  finishSM(pB0, pB1, alB, l_reg, pa0, pa1, pa2, pa3); SBAR();
  pv_d0(o, vb0 + (int)SHM_V, pa0, pa1, pa2, pa3);
  if (hi == 0) li_l[r32] = l_reg; asm volatile("s_waitcnt lgkmcnt(0)" ::: "memory");
  float rli[16];
#pragma unroll
  for (int r = 0; r < 16; ++r) rli[r] = __builtin_amdgcn_rcpf(li_l[crow(r, hi)]);
  unsigned short* Ow = Ob + (long)(wid * QBLK) * LDO;
#pragma unroll
  for (int r = 0; r < 16; ++r) { int orow = crow(r, hi);
    for (int d0 = 0; d0 < 4; ++d0) Ow[(long)orow * LDO + d0 * 32 + r32] = f2bf_att(o[d0][r] * rli[r]); }
#undef SLOAD
#undef SWRITE
#undef SWAIT
#undef RESC
}
}

#define MFMA16(a, b, c) __builtin_amdgcn_mfma_f32_16x16x32_bf16((a), (b), (c), 0, 0, 0)
#define LDS_BAR() do { asm volatile("s_waitcnt lgkmcnt(0)" ::: "memory"); __builtin_amdgcn_s_barrier(); asm volatile("" ::: "memory"); } while (0)

__device__ __forceinline__ bf16x8_t tr_frag(const void* base, int rs, int k0, int n0, int lane) {
  const int g = lane >> 4, qq = (lane & 15) >> 2, pp = lane & 3;
  const unsigned a0 = (unsigned)(uintptr_t)base + (unsigned)((k0 + 8 * g + qq) * rs + (n0 + 4 * pp) * 2);
  const unsigned a1 = a0 + 4u * (unsigned)rs;
  s16x4_t lo, hi;
  asm volatile("ds_read_b64_tr_b16 %0, %2\n\tds_read_b64_tr_b16 %1, %3\n\ts_waitcnt lgkmcnt(0)" : "=&v"(lo), "=&v"(hi) : "v"(a0), "v"(a1) : "memory");
  return (bf16x8_t){lo[0], lo[1], lo[2], lo[3], hi[0], hi[1], hi[2], hi[3]};
}

struct WJob { const float* src; int ld, col0, K, N, Npad; bf16_t* dst; };
__device__ __forceinline__ WJob get_wjob(const Params& p, int j) {
  unsigned char* ws = p.ws; WJob w;
  if (j < 4)       { w.src = p.in[7] + (size_t)j * DM * DFF; w.ld = DFF; w.col0 = 0; w.K = DM; w.N = DFF; w.Npad = DFF; w.dst = (bf16_t*)(ws + WT_W1) + (size_t)j * DM * DFF; }
  else if (j < 8)  { w.src = p.in[8] + (size_t)(j - 4) * DM * DFF; w.ld = DM; w.col0 = 0; w.K = DFF; w.N = DM; w.Npad = DM; w.dst = (bf16_t*)(ws + WT_W2) + (size_t)(j - 4) * DM * DFF; }
  else if (j == 8) { w.src = p.in[9]; w.ld = 1536; w.col0 = 0; w.K = DM; w.N = 1536; w.Npad = 1536; w.dst = (bf16_t*)(ws + WT_GQKV); }
  else if (j == 9) { w.src = p.in[12]; w.ld = DM; w.col0 = 0; w.K = DM; w.N = DM; w.Npad = DM; w.dst = (bf16_t*)(ws + WT_GO); }
  else if (j == 10){ w.src = p.in[21]; w.ld = DM; w.col0 = 0; w.K = DM; w.N = DM; w.Npad = DM; w.dst = (bf16_t*)(ws + WT_GLU); }
  else if (j == 11){ w.src = p.in[23]; w.ld = 5184; w.col0 = 2048; w.K = DM; w.N = 3136; w.Npad = SSD_N1; w.dst = (bf16_t*)(ws + WT_SIN1); }
  else if (j == 12){ w.src = p.in[23]; w.ld = 5184; w.col0 = 0; w.K = DM; w.N = 2048; w.Npad = 2048; w.dst = (bf16_t*)(ws + WT_SGATE); }
  else if (j == 13){ w.src = p.in[30]; w.ld = DM; w.col0 = 0; w.K = 2048; w.N = DM; w.Npad = DM; w.dst = (bf16_t*)(ws + WT_SOUT); }
  else if (j == 14){ w.src = p.in[31]; w.ld = 3072; w.col0 = 0; w.K = DM; w.N = 3072; w.Npad = 3072; w.dst = (bf16_t*)(ws + WT_NQKV); }
  else             { w.src = p.in[33]; w.ld = DM; w.col0 = 0; w.K = DM; w.N = DM; w.Npad = DM; w.dst = (bf16_t*)(ws + WT_NO); }
  return w;
}

__device__ __forceinline__ void phase_prep(const Params& p, unsigned char* lds) {
  const int tid = threadIdx.x, lane = tid & 63, wid = tid >> 6;
  float* tile = (float*)lds;
  for (int j = 0; j < 16; ++j) {
    const WJob w = get_wjob(p, j);
    const int tn = w.Npad / 64, tk = w.K / 64, nt = tn * tk;
    const int kk0 = tid >> 4, nn4 = (tid & 15) * 4;
    float4 v0 = make_float4(0.f, 0.f, 0.f, 0.f), v1 = v0;
    int t = blockIdx.x;
    if (t < nt) { const int n0 = (t % tn) * 64, k0 = (t / tn) * 64;
      if (n0 < w.N) { v0 = *(const float4*)(w.src + (size_t)(k0 + kk0) * w.ld + w.col0 + n0 + nn4); v1 = *(const float4*)(w.src + (size_t)(k0 + kk0 + 32) * w.ld + w.col0 + n0 + nn4); } }
    for (; t < nt; t += gridDim.x) {
      const int n0 = (t % tn) * 64, k0 = (t / tn) * 64;
      tile[kk0 * 65 + nn4 + 0] = v0.x; tile[kk0 * 65 + nn4 + 1] = v0.y; tile[kk0 * 65 + nn4 + 2] = v0.z; tile[kk0 * 65 + nn4 + 3] = v0.w;
      tile[(kk0 + 32) * 65 + nn4 + 0] = v1.x; tile[(kk0 + 32) * 65 + nn4 + 1] = v1.y; tile[(kk0 + 32) * 65 + nn4 + 2] = v1.z; tile[(kk0 + 32) * 65 + nn4 + 3] = v1.w;
      __syncthreads();
      { const int t2 = t + gridDim.x; v0 = make_float4(0.f, 0.f, 0.f, 0.f); v1 = v0;
        if (t2 < nt) { const int n2 = (t2 % tn) * 64, k2 = (t2 / tn) * 64;
          if (n2 < w.N) { v0 = *(const float4*)(w.src + (size_t)(k2 + kk0) * w.ld + w.col0 + n2 + nn4); v1 = *(const float4*)(w.src + (size_t)(k2 + kk0 + 32) * w.ld + w.col0 + n2 + nn4); } } }
      { const int nn = tid >> 3, kk8 = (tid & 7) * 8; float f[8];
#pragma unroll
        for (int q = 0; q < 8; ++q) f[q] = tile[(kk8 + q) * 65 + nn];
        *(uint4*)(w.dst + (size_t)(n0 + nn) * w.K + k0 + kk8) = pack8(f); }
      __syncthreads();
    }
  }
  float* sc = (float*)lds;
  float* red = sc + 9 * 1024;
  const float* c = p.in[1]; const float* cc = p.in[3]; const float* ada_w = p.in[4]; const float* ada_b = p.in[5];
  float* MOD = (float*)(p.ws + WS_MOD);
  __syncthreads();
  for (int i = tid; i < 9 * 1024; i += 512) { const float v = (i < 8192) ? c[i] : cc[i - 8192]; sc[i] = v / (1.0f + expf(-v)); }
  __syncthreads();
  for (int t = blockIdx.x; t < 384; t += gridDim.x) {
    const int l = t / 96, n0 = (t % 96) * 64;
    const float* W = ada_w + (size_t)l * DM * 6144 + n0 + lane;
    float acc[9];
#pragma unroll
    for (int b = 0; b < 9; ++b) acc[b] = 0.f;
    const int kb = wid * 128;
#pragma unroll 32
    for (int k = kb; k < kb + 128; ++k) { const float wv = W[(size_t)k * 6144];
#pragma unroll
      for (int b = 0; b < 9; ++b) acc[b] += sc[b * 1024 + k] * wv; }
#pragma unroll
    for (int b = 0; b < 9; ++b) red[(wid * 9 + b) * 64 + lane] = acc[b];
    __syncthreads();
    for (int i = tid; i < 9 * 64; i += 512) { const int b = i >> 6, ln = i & 63; float s = 0.f;
#pragma unroll
      for (int w8 = 0; w8 < 8; ++w8) s += red[(w8 * 9 + b) * 64 + ln];
      MOD[((size_t)l * 9 + b) * 6144 + n0 + ln] = s + ada_b[(size_t)l * 6144 + n0 + ln]; }
    __syncthreads();
  }
  {
    const float* a_re = p.in[13]; const float* a_im = p.in[14]; const float* log_dt = p.in[15]; const float* b_re = p.in[16]; const float* b_im = p.in[17];
    float2* ABAR = (float2*)(p.ws + WS_S5A); float2* AT = ABAR + 8192; float2* BBAR = AT + 8192;
    for (int idx = blockIdx.x * 512 + tid; idx < 8192; idx += gridDim.x * 512) {
      const int dg = idx >> 6;
      const double lr = (double)a_re[idx], li = (double)a_im[idx], dt = exp((double)log_dt[dg]);
      const double er = exp(lr * dt), ar = er * cos(li * dt), ai = er * sin(li * dt);
      const double e64 = exp(lr * dt * 64.0), tr = e64 * cos(li * dt * 64.0), ti = e64 * sin(li * dt * 64.0);
      ABAR[idx] = make_float2((float)ar, (float)ai); AT[idx] = make_float2((float)tr, (float)ti);
      const double nr = ar - 1.0, ni = ai, den = lr * lr + li * li;
      const double cr = (nr * lr + ni * li) / den, ci = (ni * lr - nr * li) / den;
      for (int cch = 0; cch < 16; ++cch) { const double br = (double)b_re[(size_t)idx * 16 + cch], bi = (double)b_im[(size_t)idx * 16 + cch];
        BBAR[(size_t)idx * 16 + cch] = make_float2((float)(cr * br - ci * bi), (float)(cr * bi + ci * br)); }
    }
  }
}

struct RowArgs { const bf16_t* Y; int g_post, m_gate; int do_norm, g_pre, m_shift, m_scale; int init, skip_ctx; const bf16_t* part; int ks; const bf16_t* glu_g; const float* glu_b; };
__device__ __forceinline__ void phase_row(const Params& p, const RowArgs a) {
  const int tid = threadIdx.x, lane = tid & 63, wid = tid >> 6;
  const float* NG = p.in[6]; const float* MOD = (const float*)(p.ws + WS_MOD);
  bf16_t* XB = (bf16_t*)(p.ws + WS_XB); bf16_t* H = (bf16_t*)p.out;
  const bool fin = !a.do_norm;
  const int gw = blockIdx.x * 8 + wid, nw = gridDim.x * 8;
  float4 xr0 = make_float4(0.f, 0.f, 0.f, 0.f), xr1 = xr0, xr2 = xr0, xr3 = xr0; uint2 xq0 = make_uint2(0u, 0u), xq1 = xq0, xq2 = xq0, xq3 = xq0;
  uint2 yr0 = make_uint2(0u, 0u), yr1 = yr0, yr2 = yr0, yr3 = yr0;
#define ROW_LOAD(R) do { \
    if (a.init) { const int b_ = (R) / TT, t_ = (R) - b_ * TT; \
      const float* xi_ = (t_ < CTXL) ? p.in[2] + ((size_t)b_ * CTXL + t_) * DM : p.in[0] + ((size_t)b_ * SEQ + (t_ - CTXL)) * DM; \
      xr0 = *(const float4*)(xi_ + lane * 4); xr1 = *(const float4*)(xi_ + 256 + lane * 4); xr2 = *(const float4*)(xi_ + 512 + lane * 4); xr3 = *(const float4*)(xi_ + 768 + lane * 4); } \
    else { const bf16_t* xi_ = XB + (size_t)(R) * DM + lane * 4; xq0 = *(const uint2*)(xi_); xq1 = *(const uint2*)(xi_ + 256); xq2 = *(const uint2*)(xi_ + 512); xq3 = *(const uint2*)(xi_ + 768); } \
    if (a.Y) { const bf16_t* yi_ = a.Y + (size_t)(R) * DM + lane * 4; yr0 = *(const uint2*)(yi_); yr1 = *(const uint2*)(yi_ + 256); yr2 = *(const uint2*)(yi_ + 512); yr3 = *(const uint2*)(yi_ + 768); } } while (0)
  if (gw < MR) ROW_LOAD(gw);
  for (int row = gw; row < MR; row += nw) {
    const int b = row / TT, t = row - b * TT;
    const bool isctx = t < CTXL;
    float x[16]; uint2 yc[4];
    if (a.init) { x[0] = xr0.x; x[1] = xr0.y; x[2] = xr0.z; x[3] = xr0.w; x[4] = xr1.x; x[5] = xr1.y; x[6] = xr1.z; x[7] = xr1.w;
      x[8] = xr2.x; x[9] = xr2.y; x[10] = xr2.z; x[11] = xr2.w; x[12] = xr3.x; x[13] = xr3.y; x[14] = xr3.z; x[15] = xr3.w; }
    else { const uint2 q4[4] = {xq0, xq1, xq2, xq3};
#pragma unroll
      for (int j = 0; j < 4; ++j) { const h16x4_t hv = __builtin_bit_cast(h16x4_t, q4[j]); x[4 * j] = (float)hv[0]; x[4 * j + 1] = (float)hv[1]; x[4 * j + 2] = (float)hv[2]; x[4 * j + 3] = (float)hv[3]; } }
    yc[0] = yr0; yc[1] = yr1; yc[2] = yr2; yc[3] = yr3;
    if (row + nw < MR) ROW_LOAD(row + nw);
    if (isctx && a.skip_ctx) continue;
    const int b9 = isctx ? 8 : b;
    if (a.Y) {
      float y[16]; float ss = 0.f;
#pragma unroll
      for (int j = 0; j < 4; ++j) {
        if (isctx && a.part) { y[4 * j] = 0.f; y[4 * j + 1] = 0.f; y[4 * j + 2] = 0.f; y[4 * j + 3] = 0.f;
          for (int ks = 0; ks < a.ks; ++ks) { const uint2 v = *(const uint2*)(a.part + ((size_t)b * CTXL + t) * (size_t)(a.ks * DM) + ks * DM + j * 256 + lane * 4);
            y[4 * j] += __uint_as_float(v.x << 16); y[4 * j + 1] += __uint_as_float(v.x & 0xffff0000u); y[4 * j + 2] += __uint_as_float(v.y << 16); y[4 * j + 3] += __uint_as_float(v.y & 0xffff0000u); }
          if (a.glu_g) {
            const uint2 gv = *(const uint2*)(a.glu_g + (size_t)row * DM + j * 256 + lane * 4); const float4 bv = *(const float4*)(a.glu_b + j * 256 + lane * 4);
            y[4 * j] = __uint_as_float(gv.x << 16) * frcp(1.0f + __expf(-(y[4 * j] + bv.x))); y[4 * j + 1] = __uint_as_float(gv.x & 0xffff0000u) * frcp(1.0f + __expf(-(y[4 * j + 1] + bv.y)));
            y[4 * j + 2] = __uint_as_float(gv.y << 16) * frcp(1.0f + __expf(-(y[4 * j + 2] + bv.z))); y[4 * j + 3] = __uint_as_float(gv.y & 0xffff0000u) * frcp(1.0f + __expf(-(y[4 * j + 3] + bv.w))); } }
        else { const uint2 v = yc[j];
          y[4 * j] = __uint_as_float(v.x << 16); y[4 * j + 1] = __uint_as_float(v.x & 0xffff0000u); y[4 * j + 2] = __uint_as_float(v.y << 16); y[4 * j + 3] = __uint_as_float(v.y & 0xffff0000u); } }
#pragma unroll
      for (int e = 0; e < 16; ++e) ss += y[e] * y[e];
      ss = wave_sum(ss); const float rs = rsqrtf(ss * (1.0f / DM) + EPS);
      const float* gp = NG + (size_t)a.g_post * DM; const float* gate = MOD + ((size_t)(a.m_gate / 6) * 9 + b9) * 6144 + (a.m_gate % 6) * DM;
#pragma unroll
      for (int j = 0; j < 4; ++j) { const float4 gv = *(const float4*)(gp + j * 256 + lane * 4); const float4 tv = *(const float4*)(gate + j * 256 + lane * 4);
        x[4 * j] += tv.x * (y[4 * j] * rs * gv.x); x[4 * j + 1] += tv.y * (y[4 * j + 1] * rs * gv.y); x[4 * j + 2] += tv.z * (y[4 * j + 2] * rs * gv.z); x[4 * j + 3] += tv.w * (y[4 * j + 3] * rs * gv.w); }
    }
    if (fin) {
      float* op = p.out + ((size_t)b * SEQ + (t - CTXL)) * DM;
#pragma unroll
      for (int j = 0; j < 4; ++j) *(float4*)(op + j * 256 + lane * 4) = make_float4(x[4 * j], x[4 * j + 1], x[4 * j + 2], x[4 * j + 3]);
    } else if (a.Y || a.init) {
#pragma unroll
      for (int j = 0; j < 4; ++j) { const h16x4_t hv = {(_Float16)x[4 * j], (_Float16)x[4 * j + 1], (_Float16)x[4 * j + 2], (_Float16)x[4 * j + 3]};
        *(uint2*)(XB + (size_t)row * DM + j * 256 + lane * 4) = __builtin_bit_cast(uint2, hv); }
    }
    if (a.do_norm) {
      float ss = 0.f;
#pragma unroll
      for (int e = 0; e < 16; ++e) ss += x[e] * x[e];
      ss = wave_sum(ss); const float rs = rsqrtf(ss * (1.0f / DM) + EPS);
      const float* gp = NG + (size_t)a.g_pre * DM;
      const float* sh = MOD + ((size_t)(a.m_shift / 6) * 9 + b9) * 6144 + (a.m_shift % 6) * DM;
      const float* scl = MOD + ((size_t)(a.m_scale / 6) * 9 + b9) * 6144 + (a.m_scale % 6) * DM;
#pragma unroll
      for (int j = 0; j < 4; ++j) { const float4 gv = *(const float4*)(gp + j * 256 + lane * 4); const float4 sv = *(const float4*)(sh + j * 256 + lane * 4); const float4 cv = *(const float4*)(scl + j * 256 + lane * 4);
        const float h0 = x[4 * j] * rs * gv.x * (1.0f + cv.x) + sv.x, h1 = x[4 * j + 1] * rs * gv.y * (1.0f + cv.y) + sv.y;
        const float h2 = x[4 * j + 2] * rs * gv.z * (1.0f + cv.z) + sv.z, h3 = x[4 * j + 3] * rs * gv.w * (1.0f + cv.w) + sv.w;
        uint2 o; o.x = pk2(h0, h1); o.y = pk2(h2, h3);
        *(uint2*)(H + (size_t)row * DM + j * 256 + lane * 4) = o; }
    }
  }
}

template <int ACT>
__device__ __forceinline__ void phase_gemm(unsigned char* lds, const bf16_t* A, const bf16_t* Bt, int N, int K, bf16_t* O, int ldc, const float* bias, const bf16_t* aux) {
  pg8::Gemm g{A, Bt, MR, N, K, K, K}; pg8::StaticOrder S; S.init(MR, N, (int)gridDim.x, (int)blockIdx.x, K, K);
  pg8::EpiB<ACT> E{O, ldc, bias, aux};
  pg8::gemm_phase<pg8::EpiB<ACT>, pg8::StaticOrder, false>((PG8_LAS unsigned char*)lds, g, S, E, nullptr);
  __syncthreads();
}
template <int ACT>
__device__ __forceinline__ void phase_gemm_lat(unsigned char* lds, const bf16_t* A, const bf16_t* Bt, int N, int K, bf16_t* O, int ldc, const float* bias = nullptr, const bf16_t* aux = nullptr) {
  pg8::Gemm g{A, Bt, MR, N, K, K, K}; pg8::LatOrder S; S.init(N, (int)gridDim.x, (int)blockIdx.x, K, K);
  pg8::EpiB<ACT> E{O, ldc, bias, aux};
  pg8::gemm_phase<pg8::EpiB<ACT>, pg8::LatOrder, false>((PG8_LAS unsigned char*)lds, g, S, E, nullptr);
  __syncthreads();
}
__device__ __forceinline__ void phase_gemm_ctxsplit(unsigned char* lds, const bf16_t* A, const bf16_t* Bt, int N, int K, int KS, bf16_t* PART) {
  pg8::Gemm g{A, Bt, MR, N, K / KS, K, K}; pg8::CtxSplitOrder S; S.init(N, KS, K / KS, (int)gridDim.x, (int)blockIdx.x, K, K);
  pg8::EpiB<0> E{PART, KS * N, nullptr, nullptr};
  pg8::gemm_phase<pg8::EpiB<0>, pg8::CtxSplitOrder, false>((PG8_LAS unsigned char*)lds, g, S, E, nullptr);
  __syncthreads();
}

__device__ __forceinline__ void phase_gqa_qknorm(const Params& p, bf16_t* QKV) {
  const int tid = threadIdx.x, lane = tid & 63, wid = tid >> 6;
  const float* qn = p.in[10]; const float* kn = p.in[11];
  const int gw = blockIdx.x * 8 + wid, nw = gridDim.x * 8;
  const int hf = lane >> 5, i = lane & 31, d1 = hf * 64 + i, d2 = d1 + 32;
  const float inv = exp2f(-(float)i * (13.287712379549449f / 32.0f));
  const float gq1 = qn[d1], gq2 = qn[d2], gk1 = kn[d1], gk2 = kn[d2];
  for (int row = gw; row < MR; row += nw) {
    const int t = row % TT;
    bf16_t* base = QKV + (size_t)row * 1536;
    bf16_t r1[10], r2[10];
#pragma unroll
    for (int hd = 0; hd < 10; ++hd) { const int off = hd < 8 ? hd * 128 : 1024 + (hd - 8) * 128; r1[hd] = base[off + d1]; r2[hd] = base[off + d2]; }
    float sn = 0.f, cs = 1.f;
    if (t >= CTXL) { const int tl = t - CTXL; const float pos = hf ? (float)(tl & 63) : (float)(tl >> 6); sincosf(pos * inv, &sn, &cs); }
#pragma unroll
    for (int hd = 0; hd < 10; ++hd) { const int off = hd < 8 ? hd * 128 : 1024 + (hd - 8) * 128;
      float x1 = bf2f(r1[hd]), x2 = bf2f(r2[hd]);
      const float ss = wave_sum(x1 * x1 + x2 * x2); const float rs = rsqrtf(ss * (1.0f / 128.0f) + EPS);
      x1 *= rs * (hd < 8 ? gq1 : gk1); x2 *= rs * (hd < 8 ? gq2 : gk2);
      const float o1 = x1 * cs - x2 * sn, o2 = x1 * sn + x2 * cs;
      base[off + d1] = f2bf(o1); base[off + d2] = f2bf(o2); }
  }
}

__device__ __forceinline__ void phase_gqa_attn(unsigned char* lds, const bf16_t* QKV, bf16_t* Ob) {
  for (int u = blockIdx.x; u < 576; u += gridDim.x) {
    const bf16_t *Q, *K; bf16_t* O; int seq;
    if (u < 512) { const int b = u >> 6, h = (u >> 3) & 7, qb = u & 7;
      Q = QKV + ((size_t)b * TT + CTXL + qb * 256) * 1536 + h * 128; K = QKV + (size_t)b * TT * 1536 + 1024 + (h >> 2) * 128;
      O = Ob + ((size_t)b * TT + CTXL + qb * 256) * DM + h * 128; seq = TT; }
    else { const int uu = u - 512, b = uu >> 3, h = uu & 7;
      Q = QKV + (size_t)b * TT * 1536 + h * 128; K = QKV + (size_t)b * TT * 1536 + 1024 + (h >> 2) * 128;
      O = Ob + (size_t)b * TT * DM + h * 128; seq = CTXL; }
    att::attn_dense_body<att::bf16>(Q, K, K + 256, O, seq, (char*)lds);
    __syncthreads();
  }
}

__device__ __forceinline__ int s5_seqidx(int k, int dir) { return dir == 0 ? k : (k < 4 ? 3 - k : 39 - k); }
__device__ __forceinline__ int s5_seq8(int cn, int dir) { return dir == 0 ? cn : (cn < 32 ? 31 - cn : 319 - cn); }
__device__ __forceinline__ float2 cmulf(float2 a, float2 b) { return make_float2(a.x * b.x - a.y * b.y, a.x * b.y + a.y * b.x); }

__device__ __forceinline__ void s5_build_tables(const Params& p, unsigned char* lds) {
  const int tid = threadIdx.x;
  const float2* ABAR = (const float2*)(p.ws + WS_S5A); const float2* BBAR = ABAR + 16384;
  const float* c_re = p.in[18]; const float* c_im = p.in[19];
  bf16_t* ET = (bf16_t*)(p.ws + WS_S5T); bf16_t* FT = ET + 128 * 16384; bf16_t* KFT = FT + 128 * 16384;
  float2* PW = (float2*)lds;
  float* Kt = (float*)(PW + 512);
  for (int job = blockIdx.x; job < 256; job += gridDim.x) {
    const int gd = job & 127, part = job >> 7, dir = gd >> 6;
    const int pp = tid >> 3, j = tid & 7;
    const float2 a = ABAR[gd * 64 + pp];
    if (part == 0) {
      { float2 w = make_float2(1.f, 0.f); for (int q = 0; q < j; ++q) w = cmulf(w, a); PW[pp * 8 + j] = w; }
      __syncthreads();
      { const float2 w = PW[pp * 8 + (dir == 0 ? 7 - j : j)];
        for (int c = 0; c < 16; ++c) { const float2 v = cmulf(w, BBAR[(size_t)(gd * 64 + pp) * 16 + c]);
          ET[(size_t)gd * 16384 + (2 * pp) * 128 + j * 16 + c] = f2bf(v.x); ET[(size_t)gd * 16384 + (2 * pp + 1) * 128 + j * 16 + c] = f2bf(v.y); } }
      for (int q = 0; q < 4; ++q) { const int idx = tid * 4 + q, tau = idx >> 8, c = (idx >> 4) & 15, c2 = idx & 15; float acc = 0.f;
        for (int p2 = 0; p2 < 64; ++p2) { const float2 cc = make_float2(c_re[((size_t)gd * 16 + c) * 64 + p2], c_im[((size_t)gd * 16 + c) * 64 + p2]);
          const float2 z = cmulf(cc, PW[p2 * 8 + tau]); const float2 bb = BBAR[(size_t)(gd * 64 + p2) * 16 + c2]; acc += z.x * bb.x - z.y * bb.y; }
        Kt[idx] = acc; }
      __syncthreads();
      for (int q = 0; q < 8; ++q) { const int idx = tid * 8 + q, dl = idx >> 9, c = (idx >> 5) & 15, k = idx & 31; float v;
        if (dir == 0) v = k < 16 ? Kt[(dl * 16 + c) * 16 + k] : (dl >= 1 ? Kt[((dl - 1) * 16 + c) * 16 + k - 16] : 0.f);
        else          v = k < 16 ? (dl >= 1 ? Kt[((dl - 1) * 16 + c) * 16 + k] : 0.f) : Kt[(dl * 16 + c) * 16 + k - 16];
        KFT[(size_t)gd * 4096 + idx] = f2bf(v); }
      __syncthreads();
    } else {
      const int e = dir == 0 ? j + 1 : 8 - j; float2 z0 = make_float2(1.f, 0.f); for (int q = 0; q < e; ++q) z0 = cmulf(z0, a);
      for (int c = 0; c < 16; ++c) { const float2 cc = make_float2(c_re[((size_t)gd * 16 + c) * 64 + pp], c_im[((size_t)gd * 16 + c) * 64 + pp]); const float2 z = cmulf(cc, z0);
        FT[(size_t)gd * 16384 + (j * 16 + c) * 128 + 2 * pp] = f2bf(z.x); FT[(size_t)gd * 16384 + (j * 16 + c) * 128 + 2 * pp + 1] = f2bf(-z.y); }
    }
  }
}

__device__ __forceinline__ void s5_load_tab(bf16_t* dst, const bf16_t* src, int tid) {
#pragma unroll
  for (int it = 0; it < 4; ++it) { const int idx = tid + it * 512, row = idx >> 4, ch = idx & 15; *(uint4*)(dst + row * 136 + ch * 8) = *(const uint4*)(src + row * 128 + ch * 8); }
}
__device__ __forceinline__ void s5_load_u(bf16x8_t (&uf)[4], const bf16_t* H, int b, int g, int ct, int fr, int fq) {
#pragma unroll
  for (int ks = 0; ks < 4; ++ks) uf[ks] = *(const bf16x8_t*)(H + ((size_t)b * TT + ct * 128 + fr * 8 + 2 * ks + (fq >> 1)) * DM + g * 16 + 8 * (fq & 1));
}

__device__ __forceinline__ void phase_s5_local(const Params& p, unsigned char* lds, bf16_t* SLOC) {
  const int tid = threadIdx.x, lane = tid & 63, wid = tid >> 6, fr = lane & 15, fq = lane >> 4;
  const bf16_t* H = (const bf16_t*)p.out;
  const bf16_t* ET = (const bf16_t*)(p.ws + WS_S5T);
  bf16_t* El = (bf16_t*)lds;
  for (int job = blockIdx.x; job < 256; job += gridDim.x) {
    const int gd = job & 127, half = job >> 7, dir = gd >> 6, g = gd & 63;
    __syncthreads();
    s5_load_tab(El, ET + (size_t)gd * 16384, tid);
    __syncthreads();
    for (int i = 0; i < 9; ++i) {
      const int cti = half * 72 + wid * 9 + i, b = cti / 18, ct = cti - b * 18;
      bf16x8_t uf[4]; s5_load_u(uf, H, b, g, ct, fr, fq);
      const int cn = ct * 16 + fr;
      bf16_t* dst = SLOC + ((size_t)((b * 64 + g) * 2 + dir) * 288 + s5_seq8(cn, dir)) * 128;
#pragma unroll
      for (int rt = 0; rt < 8; ++rt) { f32x4_t acc = (f32x4_t){0.f, 0.f, 0.f, 0.f};
#pragma unroll
        for (int ks = 0; ks < 4; ++ks) { const bf16x8_t af = *(const bf16x8_t*)(El + (16 * rt + fr) * 136 + 32 * ks + 8 * fq); acc = MFMA16(af, uf[ks], acc); }
        uint2 o; o.x = pk2(acc[0], acc[1]); o.y = pk2(acc[2], acc[3]);
        *(uint2*)(dst + 16 * rt + 4 * fq) = o; }
    }
  }
}

__device__ __forceinline__ void phase_s5_carry(const Params& p, const bf16_t* SLOC, bf16_t* SIN) {
  const float2* ABAR = (const float2*)(p.ws + WS_S5A);
  for (int idx = blockIdx.x * 512 + threadIdx.x; idx < NB * 64 * 2 * 64; idx += gridDim.x * 512) {
    const int pp = idx & 63, bgd = idx >> 6; const int dir = bgd & 1, g = (bgd >> 1) & 63;
    float2 a = ABAR[(dir * 64 + g) * 64 + pp]; a = cmulf(a, a); a = cmulf(a, a); a = cmulf(a, a);
    float sr = 0.f, si = 0.f;
    const unsigned* src = (const unsigned*)(SLOC + (size_t)bgd * 288 * 128) + pp; unsigned* dst = (unsigned*)(SIN + (size_t)bgd * 288 * 128) + pp;
    for (int kk0 = 0; kk0 < 288; kk0 += 32) {
      unsigned lv[32];
#pragma unroll
      for (int j = 0; j < 32; ++j) lv[j] = src[(kk0 + j) * 64];
#pragma unroll
      for (int j = 0; j < 32; ++j) { const unsigned l = lv[j];
        dst[(kk0 + j) * 64] = pk2(sr, si);
        const float lr = __uint_as_float(l << 16), li = __uint_as_float(l & 0xffff0000u);
        const float nr = a.x * sr - a.y * si + lr, ni = a.x * si + a.y * sr + li; sr = nr; si = ni; } }
  }
}

__device__ __forceinline__ void phase_s5_full(const Params& p, unsigned char* lds, const bf16_t* SIN, bf16_t* G) {
  const int tid = threadIdx.x, lane = tid & 63, wid = tid >> 6, fr = lane & 15, fq = lane >> 4;
  const bf16_t* H = (const bf16_t*)p.out;
  const bf16_t* FT = (const bf16_t*)(p.ws + WS_S5T) + 128 * 16384; const bf16_t* KFT = FT + 128 * 16384;
  const float* dsk = p.in[20];
  bf16_t* Fl = (bf16_t*)lds;
  bf16_t* Kl = Fl + 2 * 128 * 136;
  for (int job = blockIdx.x; job < 256; job += gridDim.x) {
    const int g = job & 63, quarter = job >> 6;
    __syncthreads();
    s5_load_tab(Fl, FT + (size_t)g * 16384, tid); s5_load_tab(Fl + 128 * 136, FT + (size_t)(64 + g) * 16384, tid);
    { const int d = tid >> 8, idx = tid & 255; *(uint4*)(Kl + d * 4096 + idx * 8) = *(const uint4*)(KFT + (size_t)(d * 64 + g) * 4096 + idx * 8);
      *(uint4*)(Kl + d * 4096 + 2048 + idx * 8) = *(const uint4*)(KFT + (size_t)(d * 64 + g) * 4096 + 2048 + idx * 8); }
    __syncthreads();
    for (int i = wid; i < 36; i += 8) {
      const int cti = quarter * 36 + i, b = cti / 18, ct = cti - b * 18;
      bf16x8_t uf[4]; s5_load_u(uf, H, b, g, ct, fr, fq);
      const int cn = ct * 16 + fr;
      f32x4_t acc[8];
#pragma unroll
      for (int t = 0; t < 8; ++t) acc[t] = (f32x4_t){0.f, 0.f, 0.f, 0.f};
      bf16x8_t sfa[2][4]; uint2 hv8[8];
#pragma unroll
      for (int dir = 0; dir < 2; ++dir) { const bf16_t* sp = SIN + ((size_t)((b * 64 + g) * 2 + dir) * 288 + s5_seq8(cn, dir)) * 128;
#pragma unroll
        for (int ks = 0; ks < 4; ++ks) sfa[dir][ks] = *(const bf16x8_t*)(sp + 32 * ks + 8 * fq); }
#pragma unroll
      for (int t = 0; t < 8; ++t) hv8[t] = *(const uint2*)(H + ((size_t)b * TT + ct * 128 + fr * 8 + t) * DM + g * 16 + 4 * fq);
#pragma unroll
      for (int dir = 0; dir < 2; ++dir) {
        bf16x8_t sf[4];
#pragma unroll
        for (int ks = 0; ks < 4; ++ks) sf[ks] = sfa[dir][ks];
        const bf16_t* Kd = Kl + dir * 4096; const bf16_t* Fd = Fl + dir * 128 * 136;
#pragma unroll
        for (int t = 0; t < 8; ++t) {
#pragma unroll
          for (int ks = 0; ks < 4; ++ks) { const int dl = dir == 0 ? t - 2 * ks : 2 * ks + 1 - t;
            if (dl >= 0) { const bf16x8_t af = *(const bf16x8_t*)(Kd + (dl * 16 + fr) * 32 + 8 * fq); acc[t] = MFMA16(af, uf[ks], acc[t]); } }
#pragma unroll
          for (int ks = 0; ks < 4; ++ks) { const bf16x8_t af = *(const bf16x8_t*)(Fd + (t * 16 + fr) * 136 + 32 * ks + 8 * fq); acc[t] = MFMA16(af, sf[ks], acc[t]); }
          __builtin_amdgcn_sched_barrier(0);
        }
      }
      const float4 dv = *(const float4*)(dsk + g * 16 + 4 * fq);
#pragma unroll
      for (int t = 0; t < 8; ++t) { const size_t off = ((size_t)b * TT + ct * 128 + fr * 8 + t) * DM + g * 16 + 4 * fq;
        const uint2 hv = hv8[t];
        const float h0 = __uint_as_float(hv.x << 16), h1 = __uint_as_float(hv.x & 0xffff0000u), h2 = __uint_as_float(hv.y << 16), h3 = __uint_as_float(hv.y & 0xffff0000u);
        float z[4] = {h0 * dv.x + acc[t][0], h1 * dv.y + acc[t][1], h2 * dv.z + acc[t][2], h3 * dv.w + acc[t][3]};
#pragma unroll
        for (int q = 0; q < 4; ++q) { const float zz = z[q]; const float t3 = 0.7978845608028654f * (zz + 0.044715f * zz * zz * zz); z[q] = zz * frcp(1.0f + __expf(-2.0f * t3)); }
        uint2 o; o.x = pk2(z[0], z[1]); o.y = pk2(z[2], z[3]);
        *(uint2*)(G + off) = o;
        if (t & 1) __builtin_amdgcn_sched_barrier(0); }
    }
  }
}

__device__ __forceinline__ void phase_ssd_conv(const Params& p, const bf16_t* P1, bf16_t* XBC) {
  const float* cw = p.in[24]; const float* cb = p.in[25]; const float* dtb = p.in[26];
  float* DT = (float*)(p.ws + WS_DT);
  const size_t gt = (size_t)blockIdx.x * 512 + threadIdx.x, nthr = (size_t)gridDim.x * 512;
  {
    for (size_t item = gt; item < (size_t)(MR / 16) * 384; item += nthr) {
      const int cg8 = (int)(item % 384) * 8, run = (int)(item / 384); const int row0 = run * 16, t0 = row0 % TT;
      const int lo = t0 < CTXL ? 0 : CTXL, hi = t0 < CTXL ? CTXL : TT;
      float w[5][8], bs[8];
      { const float4 b0 = *(const float4*)(cb + cg8), b1 = *(const float4*)(cb + cg8 + 4); bs[0] = b0.x; bs[1] = b0.y; bs[2] = b0.z; bs[3] = b0.w; bs[4] = b1.x; bs[5] = b1.y; bs[6] = b1.z; bs[7] = b1.w; }
#pragma unroll
      for (int k = 0; k < 5; ++k) { const float4 w0 = *(const float4*)(cw + k * 3072 + cg8), w1 = *(const float4*)(cw + k * 3072 + cg8 + 4);
        w[k][0] = w0.x; w[k][1] = w0.y; w[k][2] = w0.z; w[k][3] = w0.w; w[k][4] = w1.x; w[k][5] = w1.y; w[k][6] = w1.z; w[k][7] = w1.w; }
      uint4 xr[20];
      { const int segrow0 = row0 - t0 + lo, segrow1 = row0 - t0 + hi - 1;
#pragma unroll
        for (int k = 0; k < 20; ++k) { const int rr = min(max(row0 + k - 2, segrow0), segrow1); xr[k] = *(const uint4*)(P1 + (size_t)rr * SSD_N1 + cg8); }
#pragma unroll
        for (int k = 0; k < 20; ++k) { const int tt = t0 + k - 2; if (!(tt >= lo && tt < hi)) xr[k] = make_uint4(0u, 0u, 0u, 0u); } }
      float x[5][8];
#pragma unroll
      for (int k = 0; k < 4; ++k) unpack8(xr[k], x[k + 1]);
#pragma unroll
      for (int r = 0; r < 16; ++r) {
#pragma unroll
        for (int k = 0; k < 4; ++k)
#pragma unroll
          for (int q = 0; q < 8; ++q) x[k][q] = x[k + 1][q];
        unpack8(xr[r + 4], x[4]);
        float acc[8];
#pragma unroll
        for (int q = 0; q < 8; ++q) { float sacc = bs[q];
#pragma unroll
          for (int k = 0; k < 5; ++k) sacc += w[k][q] * x[k][q];
          acc[q] = silu_f(sacc); }
        *(uint4*)(XBC + (size_t)(row0 + r) * 3072 + cg8) = pack8(acc);
      }
    }
  }
  for (size_t idx = gt; idx < (size_t)MR * 64; idx += 3 * nthr) {
    float v3[3];
#pragma unroll
    for (int u = 0; u < 3; ++u) { const size_t i2 = idx + u * nthr; v3[u] = i2 < (size_t)MR * 64 ? bf2f(P1[(size_t)(i2 >> 6) * SSD_N1 + 3072 + (int)(i2 & 63)]) + dtb[i2 & 63] : 0.f; }
#pragma unroll
    for (int u = 0; u < 3; ++u) { const size_t i2 = idx + u * nthr; if (i2 < (size_t)MR * 64) DT[i2] = v3[u] > 20.f ? v3[u] : log1pf(expf(v3[u])); }
  }
}

__device__ __forceinline__ void tr_frag2(bf16x8_t& f0, bf16x8_t& f1, const void* base0, const void* base1, int rs, int k0, int n0, int k1, int n1, int lane) {
  const int g = lane >> 4, qq = (lane & 15) >> 2, pp = lane & 3;
  const unsigned a0 = (unsigned)(uintptr_t)base0 + (unsigned)((k0 + 8 * g + qq) * rs + (n0 + 4 * pp) * 2), a1 = a0 + 4u * (unsigned)rs;
  const unsigned b0 = (unsigned)(uintptr_t)base1 + (unsigned)((k1 + 8 * g + qq) * rs + (n1 + 4 * pp) * 2), b1 = b0 + 4u * (unsigned)rs;
  s16x4_t l0, h0, l1, h1;
  asm volatile("ds_read_b64_tr_b16 %0, %4\n\tds_read_b64_tr_b16 %1, %5\n\tds_read_b64_tr_b16 %2, %6\n\tds_read_b64_tr_b16 %3, %7\n\ts_waitcnt lgkmcnt(0)"
               : "=&v"(l0), "=&v"(h0), "=&v"(l1), "=&v"(h1) : "v"(a0), "v"(a1), "v"(b0), "v"(b1) : "memory");
  f0 = (bf16x8_t){l0[0], l0[1], l0[2], l0[3], h0[0], h0[1], h0[2], h0[3]};
  f1 = (bf16x8_t){l1[0], l1[1], l1[2], l1[3], h1[0], h1[1], h1[2], h1[3]};
}
__device__ __forceinline__ void phase_ssd_scan(const Params& p, unsigned char* lds, const bf16_t* XBC, bf16_t* YS) {
  const int tid0 = threadIdx.x, wid = tid0 >> 6;
  const float* DT = (const float*)(p.ws + WS_DT); const float* a_log = p.in[27]; const float* dskip = p.in[28];
  bf16_t* Cs = (bf16_t*)lds;
  bf16_t* Bs = Cs + 64 * 136;
  bf16_t* St = Bs + 64 * 136;
  bf16_t* Xd = St + 128 * 72;
  bf16_t* Xw = Xd + 64 * 72;
  bf16_t* Xr = Xw + 64 * 72;
  bf16_t* Ps = Xr + 64 * 72;
  float* cum = (float*)(Ps + 64 * 72);
  float* dts = cum + 64;
  float* tot = dts + 64;
  for (int item = blockIdx.x; item < NB * 32; item += gridDim.x) {
    const int b = item >> 5, h = item & 31, gr = h >> 3;
    const float dsk = dskip[h];
    for (int dir = 0; dir < 2; ++dir) {
      const float a = -expf(a_log[dir * 32 + h]);
      f32x4_t S[4];
#pragma unroll
      for (int q = 0; q < 4; ++q) S[q] = (f32x4_t){0.f, 0.f, 0.f, 0.f};
      LDS_BAR();
      for (int i = tid0; i < 128 * 72 / 2; i += 512) ((unsigned*)St)[i] = 0u;
      uint4 pvb0, pvb1, pvc0, pvc1, pvx; float pdt = 0.f;
      int tid = tid0, lane = tid0 & 63, fr = lane & 15, fq = lane >> 4;
#define SSD_ISSUE(KK) do { const int k_ = s5_seqidx((KK), dir); const size_t r_ = (size_t)b * TT + k_ * 64; \
        { const int l = tid >> 4, c8 = (tid & 15) * 8; \
          pvb0 = *(const uint4*)(XBC + (r_ + l) * 3072 + 2048 + gr * 128 + c8); pvc0 = *(const uint4*)(XBC + (r_ + l) * 3072 + 2560 + gr * 128 + c8); \
          pvb1 = *(const uint4*)(XBC + (r_ + l + 32) * 3072 + 2048 + gr * 128 + c8); pvc1 = *(const uint4*)(XBC + (r_ + l + 32) * 3072 + 2560 + gr * 128 + c8); } \
        { const int l = tid >> 3, c8 = (tid & 7) * 8; pvx = *(const uint4*)(XBC + (r_ + l) * 3072 + h * 64 + c8); } \
        if (wid == 0) pdt = DT[(r_ + lane) * 64 + dir * 32 + h]; } while (0)
      SSD_ISSUE(0);
      for (int kk = 0; kk < 36; ++kk) {
        const int k = s5_seqidx(kk, dir);
        const size_t row0 = (size_t)b * TT + k * 64;
        tid = tid0; asm volatile("" : "+v"(tid)); lane = tid & 63; fr = lane & 15; fq = lane >> 4;
        const int lt = wid >> 1, l_own = 16 * lt + fr;
        LDS_BAR();
        if (wid == 0) {
          const float dtv = pdt; float c = dtv * a;
          if (dir == 0) {
#pragma unroll
            for (int o = 1; o < 64; o <<= 1) { const float t = __shfl_up(c, o); if (lane >= o) c += t; } }
          else {
#pragma unroll
            for (int o = 1; o < 64; o <<= 1) { const float t = __shfl_down(c, o); if (lane + o < 64) c += t; } }
          cum[lane] = c; dts[lane] = dtv;
          if (dir == 0 ? lane == 63 : lane == 0) tot[0] = c;
        }
        { const int l = tid >> 4, c8 = (tid & 15) * 8;
          *(uint4*)(Bs + l * 136 + c8) = pvb0; *(uint4*)(Cs + l * 136 + c8) = pvc0;
          *(uint4*)(Bs + (l + 32) * 136 + c8) = pvb1; *(uint4*)(Cs + (l + 32) * 136 + c8) = pvc1; }
        const uint4 vx = pvx;
        uint2 yold[2];
#pragma unroll
        for (int p2 = 0; p2 < 2; ++p2) yold[p2] = make_uint2(0u, 0u);
        if (dir == 1) {
#pragma unroll
          for (int p2 = 0; p2 < 2; ++p2) yold[p2] = *(const uint2*)(YS + (row0 + l_own) * 2048 + h * 64 + 16 * ((wid & 1) * 2 + p2) + 4 * fq);
        }
        LDS_BAR();
        { const int l = tid >> 3, c8 = (tid & 7) * 8;
          const float dtl = dts[l], wl = __expf(tot[0] - cum[l]); float f[8], fw[8]; unpack8(vx, f);
#pragma unroll
          for (int q = 0; q < 8; ++q) { f[q] *= dtl; fw[q] = f[q] * wl; }
          *(uint4*)(Xr + l * 72 + c8) = vx; *(uint4*)(Xd + l * 72 + c8) = pack8(f); *(uint4*)(Xw + l * 72 + c8) = pack8(fw); }
        if (kk + 1 < 36) SSD_ISSUE(kk + 1);
        LDS_BAR();
        const float cl = cum[l_own];
        {
#pragma unroll
          for (int s2 = 0; s2 < 2; ++s2) { const int st = (wid & 1) * 2 + s2; f32x4_t g = (f32x4_t){0.f, 0.f, 0.f, 0.f};
#pragma unroll
            for (int ks = 0; ks < 4; ++ks) { const bf16x8_t af = *(const bf16x8_t*)(Bs + (16 * st + fr) * 136 + 32 * ks + 8 * fq);
              const bf16x8_t bfr = *(const bf16x8_t*)(Cs + l_own * 136 + 32 * ks + 8 * fq); g = MFMA16(af, bfr, g); }
            const float4 cs4 = *(const float4*)(cum + 16 * st + 4 * fq); const float csv[4] = {cs4.x, cs4.y, cs4.z, cs4.w}; float v[4];
#pragma unroll
            for (int r = 0; r < 4; ++r) { const int sidx = 16 * st + 4 * fq + r; const bool ok = dir == 0 ? sidx <= l_own : sidx >= l_own;
              v[r] = ok ? g[r] * __expf(cl - csv[r]) : 0.f; }
            uint2 o; o.x = pk2(v[0], v[1]); o.y = pk2(v[2], v[3]);
            *(uint2*)(Ps + l_own * 72 + 16 * st + 4 * fq) = o; } }
        LDS_BAR();
        { const float el = __expf(cl);
#pragma unroll
          for (int p2 = 0; p2 < 2; ++p2) { const int pt = (wid & 1) * 2 + p2; f32x4_t y1 = (f32x4_t){0.f, 0.f, 0.f, 0.f}, y2 = y1;
            { bf16x8_t a0, a1; tr_frag2(a0, a1, Xd, Xd, 144, 0, 16 * pt, 32, 16 * pt, lane);
              y1 = MFMA16(a0, *(const bf16x8_t*)(Ps + l_own * 72 + 8 * fq), y1); y1 = MFMA16(a1, *(const bf16x8_t*)(Ps + l_own * 72 + 32 + 8 * fq), y1); }
#pragma unroll
            for (int kp = 0; kp < 2; ++kp) { bf16x8_t a0, a1; tr_frag2(a0, a1, St, St, 144, 64 * kp, 16 * pt, 64 * kp + 32, 16 * pt, lane);
              y2 = MFMA16(a0, *(const bf16x8_t*)(Cs + l_own * 136 + 64 * kp + 8 * fq), y2); y2 = MFMA16(a1, *(const bf16x8_t*)(Cs + l_own * 136 + 64 * kp + 32 + 8 * fq), y2); }
            float y[4]; uint2 ad;
            if (dir == 0) { ad = *(const uint2*)(Xr + l_own * 72 + 16 * pt + 4 * fq); } else { ad = yold[p2]; }
            const float ads = dir == 0 ? dsk : 1.0f;
            y[0] = y1[0] + el * y2[0] + ads * __uint_as_float(ad.x << 16); y[1] = y1[1] + el * y2[1] + ads * __uint_as_float(ad.x & 0xffff0000u);
            y[2] = y1[2] + el * y2[2] + ads * __uint_as_float(ad.y << 16); y[3] = y1[3] + el * y2[3] + ads * __uint_as_float(ad.y & 0xffff0000u);
            uint2 o; o.x = pk2(y[0], y[1]); o.y = pk2(y[2], y[3]);
            *(uint2*)(YS + (row0 + l_own) * 2048 + h * 64 + 16 * pt + 4 * fq) = o; } }
        LDS_BAR();
        { const float et = __expf(tot[0]); bf16x8_t b0, b1; tr_frag2(b0, b1, Bs, Bs, 272, 0, 16 * wid, 32, 16 * wid, lane);
#pragma unroll
          for (int pt = 0; pt < 4; ++pt) { f32x4_t acc = S[pt] * et; bf16x8_t a0, a1; tr_frag2(a0, a1, Xw, Xw, 144, 0, 16 * pt, 32, 16 * pt, lane);
            acc = MFMA16(a0, b0, acc); acc = MFMA16(a1, b1, acc); S[pt] = acc;
            uint2 o; o.x = pk2(acc[0], acc[1]); o.y = pk2(acc[2], acc[3]);
            *(uint2*)(St + (16 * wid + fr) * 72 + 16 * pt + 4 * fq) = o; } }
      }
    }
  }
  LDS_BAR();
}

__device__ __forceinline__ void phase_ssd_gate(const Params& p, bf16_t* YS, const bf16_t* GATE, const bf16_t* PART) {
  const int tid = threadIdx.x, lane = tid & 63, wid = tid >> 6; const float* ng = p.in[29];
  const int gw = blockIdx.x * 8 + wid, nw = gridDim.x * 8;
  for (int item0 = gw * 2; item0 < MR * 4; item0 += nw * 2) {
    size_t off[2]; uint4 yv[2], gv[2];
#pragma unroll
    for (int u = 0; u < 2; ++u) { const int item = item0 + u; off[u] = (size_t)(item >> 2) * 2048 + (item & 3) * 512 + lane * 8; yv[u] = *(const uint4*)(YS + off[u]); gv[u] = *(const uint4*)(GATE + off[u]); }
#pragma unroll
    for (int u = 0; u < 2; ++u) { const int item = item0 + u;
      float y[8], g[8]; unpack8(yv[u], y); unpack8(gv[u], g);
      { const int row = item >> 2, bb = row / TT, t = row - bb * TT;
        if (t < CTXL) {
#pragma unroll
          for (int q = 0; q < 8; ++q) g[q] = 0.f;
          for (int ks = 0; ks < 4; ++ks) { float pg[8]; unpack8(*(const uint4*)(PART + ((size_t)bb * CTXL + t) * 8192 + ks * 2048 + (item & 3) * 512 + lane * 8), pg);
#pragma unroll
            for (int q = 0; q < 8; ++q) g[q] += pg[q]; } } }
      float ss = 0.f;
#pragma unroll
      for (int q = 0; q < 8; ++q) { y[q] *= silu_f(g[q]); ss += y[q] * y[q]; }
      ss = wave_sum(ss); const float rs = rsqrtf(ss * (1.0f / 512.0f) + EPS);
      const float* gp = ng + (item & 3) * 512 + lane * 8;
#pragma unroll
      for (int q = 0; q < 8; ++q) y[q] *= rs * gp[q];
      *(uint4*)(YS + off[u]) = pack8(y); }
  }
}

__device__ __forceinline__ void tr_frag4(bf16x8_t (&f)[4], const void* base, int rs, int lane) {
  const int g = lane >> 4, qq = (lane & 15) >> 2, pp = lane & 3;
  const unsigned a0 = (unsigned)(uintptr_t)base + (unsigned)((8 * g + qq) * rs + (4 * pp) * 2), a1 = a0 + 4u * (unsigned)rs;
  s16x4_t l0, h0, l1, h1, l2, h2, l3, h3;
  asm volatile("ds_read_b64_tr_b16 %0, %8\n\tds_read_b64_tr_b16 %1, %9\n\tds_read_b64_tr_b16 %2, %8 offset:32\n\tds_read_b64_tr_b16 %3, %9 offset:32\n\t"
               "ds_read_b64_tr_b16 %4, %8 offset:64\n\tds_read_b64_tr_b16 %5, %9 offset:64\n\tds_read_b64_tr_b16 %6, %8 offset:96\n\tds_read_b64_tr_b16 %7, %9 offset:96\n\ts_waitcnt lgkmcnt(0)"
               : "=&v"(l0), "=&v"(h0), "=&v"(l1), "=&v"(h1), "=&v"(l2), "=&v"(h2), "=&v"(l3), "=&v"(h3) : "v"(a0), "v"(a1) : "memory");
  f[0] = (bf16x8_t){l0[0], l0[1], l0[2], l0[3], h0[0], h0[1], h0[2], h0[3]}; f[1] = (bf16x8_t){l1[0], l1[1], l1[2], l1[3], h1[0], h1[1], h1[2], h1[3]};
  f[2] = (bf16x8_t){l2[0], l2[1], l2[2], l2[3], h2[0], h2[1], h2[2], h2[3]}; f[3] = (bf16x8_t){l3[0], l3[1], l3[2], l3[3], h3[0], h3[1], h3[2], h3[3]};
}
__device__ __forceinline__ void phase_na_attn(const Params& p, unsigned char* lds, const bf16_t* QKV, bf16_t* Ob) {
  const int tid0 = threadIdx.x, wid = tid0 >> 6;
  const float* rpb = p.in[32];
  bf16_t* Vl = (bf16_t*)lds;
  bf16_t* Vc = Vl + 512 * 72;
  unsigned char* Kc = (unsigned char*)(Vc + 256 * 72);
  float* mbuf = (float*)(Kc + 32768);
  float* lbuf = mbuf + 128;
  float* obuf = lbuf + 128;
  float* rl = obuf + 4096;
  const int wq = wid & 3; const bool isctx = wid >= 4;
  const int c0 = 16 * wq, cbase = min(max(c0 - 8, 0), 32);
  for (int job = blockIdx.x; job < NB * 16 * 2; job += gridDim.x) {
    const int b = job >> 5, hh = (job >> 1) & 15, rbase = (job & 1) * 16;
    const size_t brow = (size_t)b * TT;
    LDS_BAR();
#pragma unroll
    for (int it = 0; it < 4; ++it) { const int idx = tid0 + it * 512, key = idx >> 3, ch = idx & 7;
      *(uint4*)(Vc + key * 72 + ch * 8) = *(const uint4*)(QKV + (brow + key) * 3072 + 2048 + hh * 64 + ch * 8);
      *(uint4*)(Kc + key * 128 + ((ch ^ (key & 7)) << 4)) = *(const uint4*)(QKV + (brow + key) * 3072 + 1024 + hh * 64 + ch * 8); }
    if (tid0 < 465) rl[tid0] = rpb[hh * 465 + tid0];
    int have_hi = -1;
    for (int ri = 0; ri < 16; ++ri) {
      int tid = tid0; asm volatile("" : "+v"(tid));
      const int lane = tid & 63, fr = lane & 15, fq = lane >> 4;
      const int qcol = c0 + fr, cs = min(max(qcol - 8, 0), 48);
      const int kap = 8 * (fr >> 2) + (fr & 3);
      const int r = rbase + ri;
      const int r0 = min(max(r - 4, 0), 24);
      for (int gr = max(r0, have_hi + 1); gr <= r0 + 7; ++gr) { const int col = tid >> 3, ch = tid & 7;
        *(uint4*)(Vl + ((gr & 7) * 64 + col) * 72 + ch * 8) = *(const uint4*)(QKV + (brow + CTXL + gr * 64 + col) * 3072 + 2048 + hh * 64 + ch * 8); }
      have_hi = r0 + 7;
      const size_t qrow = brow + CTXL + r * 64 + qcol;
      bf16x8_t qf[2];
#pragma unroll
      for (int ks = 0; ks < 2; ++ks) qf[ks] = *(const bf16x8_t*)(QKV + qrow * 3072 + hh * 64 + 32 * ks + 8 * fq);
      if (ri == 0) LDS_BAR();
      f32x4_t s[16];
      float mx = -INFINITY;
      if (isctx) {
#pragma unroll
        for (int tile = 0; tile < 16; ++tile) { const int key = 32 * (tile >> 1) + kap + 4 * (tile & 1);
          f32x4_t acc = (f32x4_t){0.f, 0.f, 0.f, 0.f};
#pragma unroll
          for (int ks = 0; ks < 2; ++ks) { const bf16x8_t kf = *(const bf16x8_t*)(Kc + key * 128 + (((4 * ks + fq) ^ (key & 7)) << 4)); acc = MFMA16(kf, qf[ks], acc); }
          acc = acc * 0.125f; mx = fmaxf(mx, fmaxf(fmaxf(acc[0], acc[1]), fmaxf(acc[2], acc[3]))); s[tile] = acc; }
      } else {
#pragma unroll
        for (int tg = 0; tg < 2; ++tg) {
          bf16x8_t kf[8][2];
#pragma unroll
          for (int t4 = 0; t4 < 8; ++t4) { const int tile = tg * 8 + t4; const size_t krow = brow + CTXL + (r0 + (tile >> 1)) * 64 + cbase + kap + 4 * (tile & 1);
            kf[t4][0] = *(const bf16x8_t*)(QKV + krow * 3072 + 1024 + hh * 64 + 8 * fq); kf[t4][1] = *(const bf16x8_t*)(QKV + krow * 3072 + 1024 + hh * 64 + 32 + 8 * fq); }
#pragma unroll
          for (int t4 = 0; t4 < 8; ++t4) { f32x4_t acc = (f32x4_t){0.f, 0.f, 0.f, 0.f}; acc = MFMA16(kf[t4][0], qf[0], acc); acc = MFMA16(kf[t4][1], qf[1], acc); s[tg * 8 + t4] = acc; }
        }
#pragma unroll
        for (int tile = 0; tile < 16; ++tile) { const int i = tile >> 1, jh = tile & 1; const int rr = r0 + i - r + 7; f32x4_t acc = s[tile];
#pragma unroll
          for (int rg = 0; rg < 4; ++rg) { const int kcol = cbase + 8 * fq + 4 * jh + rg; const bool ok = kcol >= cs && kcol < cs + 16;
            const int crl = min(max(kcol - qcol + 15, 0), 30);
            const float v = ok ? acc[rg] * 0.125f + rl[rr * 31 + crl] : -INFINITY; acc[rg] = v; mx = fmaxf(mx, v); }
          s[tile] = acc; }
      }
      mx = fmaxf(mx, __shfl_xor(mx, 16)); mx = fmaxf(mx, __shfl_xor(mx, 32));
      if (fq == 0) mbuf[wid * 16 + fr] = mx;
      LDS_BAR();
      const float Mx = fmaxf(mbuf[wq * 16 + fr], mbuf[(wq + 4) * 16 + fr]);
      float ls = 0.f;
#pragma unroll
      for (int tile = 0; tile < 16; ++tile)
#pragma unroll
        for (int rg = 0; rg < 4; ++rg) { const float e = __expf(s[tile][rg] - Mx); s[tile][rg] = e; ls += e; }
      ls += __shfl_xor(ls, 16); ls += __shfl_xor(ls, 32);
      if (fq == 0) lbuf[wid * 16 + fr] = ls;
      f32x4_t o[4];
#pragma unroll
      for (int dt = 0; dt < 4; ++dt) o[dt] = (f32x4_t){0.f, 0.f, 0.f, 0.f};
#pragma unroll
      for (int ks8 = 0; ks8 < 8; ++ks8) {
        const f32x4_t pa = s[2 * ks8], pb = s[2 * ks8 + 1];
        const u32x4_t pw = (u32x4_t){pk2(pa[0], pa[1]), pk2(pa[2], pa[3]), pk2(pb[0], pb[1]), pk2(pb[2], pb[3])};
        const bf16x8_t pf = __builtin_bit_cast(bf16x8_t, pw);
        const bf16_t* vbase = isctx ? Vc + (32 * ks8) * 72 : Vl + ((((r0 + ks8) & 7) * 64) + cbase) * 72;
        bf16x8_t vf[4]; tr_frag4(vf, vbase, 144, lane);
#pragma unroll
        for (int dt = 0; dt < 4; ++dt) o[dt] = MFMA16(pf, vf[dt], o[dt]);
      }
      if (isctx) {
#pragma unroll
        for (int dt = 0; dt < 4; ++dt)
#pragma unroll
          for (int rg = 0; rg < 4; ++rg) obuf[(wq * 16 + 4 * fq + rg) * 64 + 16 * dt + fr] = o[dt][rg];
      }
      LDS_BAR();
      if (!isctx) {
#pragma unroll
        for (int rg = 0; rg < 4; ++rg) { const int qi = 4 * fq + rg; const float lt = lbuf[wq * 16 + qi] + lbuf[(wq + 4) * 16 + qi]; const float il = frcp(lt);
          bf16_t* op = Ob + (brow + CTXL + r * 64 + c0 + qi) * DM + hh * 64;
#pragma unroll
          for (int dt = 0; dt < 4; ++dt) op[16 * dt + fr] = f2bf((o[dt][rg] + obuf[(wq * 16 + qi) * 64 + 16 * dt + fr]) * il); }
      }
    }
  }
  LDS_BAR();
}

constexpr int NPHASE = 35;
__global__ void __launch_bounds__(512, 2) mega_fwd(Params p) {
  extern __shared__ __attribute__((aligned(16))) unsigned char lds[];
  cg::grid_group grid = cg::this_grid();
  unsigned char* ws = p.ws;
  bf16_t* H = (bf16_t*)p.out;
  unsigned char* BIG = ws + WS_BIG;
  int ph = 0;
#ifndef MK_DUPMASK
#define MK_DUPMASK 0ull
#endif
  unsigned* bar = (unsigned*)(ws + WS_BAR); unsigned nbar = 0;
  const unsigned xcc = (unsigned)__builtin_amdgcn_s_getreg((3 << 11) | 20) & 0xFu;
  volatile unsigned* bst = (volatile unsigned*)(lds + 163824);
  if (threadIdx.x == 0) { bst[0] = 0u; bst[1] = 0u; __hip_atomic_fetch_add(bar + 256 + 64 * xcc, 1u, __ATOMIC_RELAXED, __HIP_MEMORY_SCOPE_AGENT); }
#define XB_LD(pw) __hip_atomic_load((pw), __ATOMIC_RELAXED, __HIP_MEMORY_SCOPE_AGENT)
#define XB_ADD(pw) __hip_atomic_fetch_add((pw), 1u, __ATOMIC_RELAXED, __HIP_MEMORY_SCOPE_AGENT)
#define GSYNC() do { if (nbar == 0) { grid.sync(); } else { \
      asm volatile("s_waitcnt vmcnt(0)" ::: "memory"); \
      __syncthreads(); \
      if (threadIdx.x == 0) { \
        unsigned nloc = bst[0], nx = bst[1]; \
        if (nloc == 0u) { for (;;) { unsigned sum = 0u, cnt = 0u, mine = 0u; \
            for (unsigned j = 0; j < 16; ++j) { const unsigned c_ = XB_LD(bar + 256 + 64 * j); sum += c_; cnt += (c_ > 0u) ? 1u : 0u; mine = (j == xcc) ? c_ : mine; } \
            if (sum == gridDim.x) { nloc = mine; nx = cnt; break; } __builtin_amdgcn_s_sleep(2); } \
          bst[0] = nloc; bst[1] = nx; } \
        const unsigned old_ = XB_ADD(bar + 1280 + 64 * xcc); const unsigned gen_ = old_ / nloc; \
        if (old_ + 1u == (gen_ + 1u) * nloc) { \
          __builtin_amdgcn_fence(__ATOMIC_RELEASE, "agent"); asm volatile("s_waitcnt vmcnt(0)" ::: "memory"); \
          const unsigned og_ = XB_ADD(bar + 3328); const unsigned tg_ = og_ / nx; \
          if (og_ + 1u == (tg_ + 1u) * nx) XB_ADD(bar + 3392); else while (XB_LD(bar + 3392) == tg_) __builtin_amdgcn_s_sleep(1); \
          __builtin_amdgcn_fence(__ATOMIC_ACQUIRE, "agent"); \
          XB_ADD(bar + 2304 + 64 * xcc); \
          asm volatile("s_waitcnt vmcnt(0)" ::: "memory"); \
        } else { \
          while (XB_LD(bar + 2304 + 64 * xcc) == gen_) __builtin_amdgcn_s_sleep(1); \
          __builtin_amdgcn_fence(__ATOMIC_ACQUIRE, "agent"); asm volatile("s_waitcnt vmcnt(0)" ::: "memory"); \
        } } \
      __syncthreads(); } ++nbar; } while (0)
#define PHASE(body) do { if (ph >= p.ph_lo && ph < p.ph_hi) { body; if ((MK_DUPMASK >> ph) & 1ull) { GSYNC(); body; } if (ph + 1 < p.ph_hi) GSYNC(); } ++ph; } while (0)
#define ROWARGS(Y, gpost, mgate, donorm, gpre, msh, msc, init, skipc) (RowArgs{(Y), (gpost), (mgate), (donorm), (gpre), (msh), (msc), (init), (skipc), nullptr, 0, nullptr, nullptr})
#define ROWARGSP(Y, gpost, mgate, donorm, gpre, msh, msc, init, skipc, part, ks) (RowArgs{(Y), (gpost), (mgate), (donorm), (gpre), (msh), (msc), (init), (skipc), (part), (ks), nullptr, nullptr})
#define PARTB ((bf16_t*)(BIG + 190 * MiB))
#define MLP(L, LAST) do { \
    if (LAST) { PHASE((phase_gemm_lat<1>(lds, H, (const bf16_t*)(ws + WT_W1) + (size_t)(L) * DM * DFF, DFF, DM, (bf16_t*)BIG, DFF))); } \
    else { PHASE((phase_gemm<1>(lds, H, (const bf16_t*)(ws + WT_W1) + (size_t)(L) * DM * DFF, DFF, DM, (bf16_t*)BIG, DFF, nullptr, nullptr))); } \
    PHASE((phase_gemm_lat<0>(lds, (const bf16_t*)BIG, (const bf16_t*)(ws + WT_W2) + (size_t)(L) * DM * DFF, DM, DFF, (bf16_t*)(BIG + 144 * MiB), DM), \
           (LAST) ? (void)0 : phase_gemm_ctxsplit(lds, (const bf16_t*)BIG, (const bf16_t*)(ws + WT_W2) + (size_t)(L) * DM * DFF, DM, DFF, 8, PARTB))); \
    PHASE((phase_row(p, ROWARGSP((const bf16_t*)(BIG + 144 * MiB), (L) * 4 + 3, (L) * 6 + 5, (LAST) ? 0 : 1, ((L) + 1) * 4 + 0, ((L) + 1) * 6 + 0, ((L) + 1) * 6 + 1, 0, (LAST) ? 1 : 0, PARTB, 8)))); \
  } while (0)

  PHASE(phase_prep(p, lds));
  PHASE((phase_row(p, ROWARGS(nullptr, 0, 0, 1, 0, 0, 1, 1, 0)), s5_build_tables(p, lds)));
  { bf16_t* QKV = (bf16_t*)BIG; bf16_t* O = (bf16_t*)(BIG + 56 * MiB); bf16_t* Y = (bf16_t*)(BIG + 96 * MiB);
    PHASE((phase_gemm<0>(lds, H, (const bf16_t*)(ws + WT_GQKV), 1536, DM, QKV, 1536, nullptr, nullptr)));
    PHASE(phase_gqa_qknorm(p, QKV));
    PHASE(phase_gqa_attn(lds, QKV, O));
    PHASE((phase_gemm_lat<0>(lds, O, (const bf16_t*)(ws + WT_GO), DM, DM, Y, DM), phase_gemm_ctxsplit(lds, O, (const bf16_t*)(ws + WT_GO), DM, DM, 4, PARTB)));
    PHASE(phase_row(p, ROWARGSP(Y, 0 * 4 + 1, 0 * 6 + 2, 1, 0 * 4 + 2, 0 * 6 + 3, 0 * 6 + 4, 0, 0, PARTB, 4)));
    MLP(0, 0); }
  { bf16_t* G = (bf16_t*)BIG; bf16_t* Y = (bf16_t*)(BIG + 40 * MiB); bf16_t* SLOC = (bf16_t*)(BIG + 80 * MiB); bf16_t* SIN = (bf16_t*)(BIG + 152 * MiB);
    PHASE(phase_s5_local(p, lds, SLOC));
    PHASE(phase_s5_carry(p, SLOC, SIN));
    PHASE(phase_s5_full(p, lds, SIN, G));
    PHASE((phase_gemm_lat<2>(lds, G, (const bf16_t*)(ws + WT_GLU), DM, DM, Y, DM, p.in[22], G), phase_gemm_ctxsplit(lds, G, (const bf16_t*)(ws + WT_GLU), DM, DM, 4, PARTB)));
    PHASE(phase_row(p, (RowArgs{Y, 1 * 4 + 1, 1 * 6 + 2, 1, 1 * 4 + 2, 1 * 6 + 3, 1 * 6 + 4, 0, 0, PARTB, 4, G, p.in[22]})));
    MLP(1, 0); }
  { bf16_t* P1 = (bf16_t*)BIG; bf16_t* XBC = (bf16_t*)(BIG + 117 * MiB); bf16_t* YS = (bf16_t*)BIG; bf16_t* Y = (bf16_t*)(BIG + 72 * MiB); bf16_t* GATE = (bf16_t*)(BIG + 117 * MiB);
    PHASE((phase_gemm<0>(lds, H, (const bf16_t*)(ws + WT_SIN1), SSD_N1, DM, P1, SSD_N1, nullptr, nullptr)));
    PHASE(phase_ssd_conv(p, P1, XBC));
    PHASE(phase_ssd_scan(p, lds, XBC, YS));
    PHASE((phase_gemm_lat<0>(lds, H, (const bf16_t*)(ws + WT_SGATE), 2048, DM, GATE, 2048), phase_gemm_ctxsplit(lds, H, (const bf16_t*)(ws + WT_SGATE), 2048, DM, 4, PARTB)));
    PHASE(phase_ssd_gate(p, YS, GATE, PARTB));
    PHASE((phase_gemm_lat<0>(lds, YS, (const bf16_t*)(ws + WT_SOUT), DM, 2048, Y, DM), phase_gemm_ctxsplit(lds, YS, (const bf16_t*)(ws + WT_SOUT), DM, 2048, 8, PARTB)));
    PHASE(phase_row(p, ROWARGSP(Y, 2 * 4 + 1, 2 * 6 + 2, 1, 2 * 4 + 2, 2 * 6 + 3, 2 * 6 + 4, 0, 0, PARTB, 8)));
    MLP(2, 0); }
  { bf16_t* QKV = (bf16_t*)BIG; bf16_t* O = (bf16_t*)(BIG + 108 * MiB); bf16_t* Y = (bf16_t*)(BIG + 144 * MiB);
    PHASE((phase_gemm<0>(lds, H, (const bf16_t*)(ws + WT_NQKV), 3072, DM, QKV, 3072, nullptr, nullptr)));
    PHASE(phase_na_attn(p, lds, QKV, O));
    PHASE((phase_gemm_lat<0>(lds, O, (const bf16_t*)(ws + WT_NO), DM, DM, Y, DM)));
    PHASE(phase_row(p, ROWARGS(Y, 3 * 4 + 1, 3 * 6 + 2, 1, 3 * 4 + 2, 3 * 6 + 3, 3 * 6 + 4, 0, 1)));
    MLP(3, 1); }
}

constexpr int LDS_BYTES = 163840;
extern "C" void kernel_launch(void* const* d_in, const int* in_sizes, int n_in, void* d_out, int out_size, void* d_ws, size_t ws_size, hipStream_t stream) {
  static int grid = 0;
  if (grid == 0) {
    if (n_in != 34 || ws_size < WS_END || out_size != NB * SEQ * DM) { fprintf(stderr, "kernel_launch: unexpected shapes (n_in %d, ws %zu need %zu, out %d)\n", n_in, ws_size, (size_t)WS_END, out_size); grid = -1; return; }
    int dev = 0, cus = 0, per_cu = 0;
    hipGetDevice(&dev); hipDeviceGetAttribute(&cus, hipDeviceAttributeMultiprocessorCount, dev);
    if (hipFuncSetAttribute((const void*)mega_fwd, hipFuncAttributeMaxDynamicSharedMemorySize, LDS_BYTES) != hipSuccess) { fprintf(stderr, "kernel_launch: hipFuncSetAttribute failed\n"); grid = -1; return; }
    if (hipOccupancyMaxActiveBlocksPerMultiprocessor(&per_cu, (const void*)mega_fwd, 512, LDS_BYTES) != hipSuccess || per_cu < 1) { fprintf(stderr, "kernel_launch: occupancy query says %d\n", per_cu); grid = -1; return; }
    grid = cus;
  }
  if (grid < 0) return;
  if (hipMemsetAsync((unsigned char*)d_ws + WS_BAR, 0, 16384, stream) != hipSuccess) { fprintf(stderr, "kernel_launch: memset failed\n"); return; }
  Params p{};
  for (int i = 0; i < 34; ++i) p.in[i] = (const float*)d_in[i];
  p.out = (float*)d_out; p.ws = (unsigned char*)d_ws;
#if MK_MULTI
  for (int ph = 0; ph < NPHASE; ++ph) { p.ph_lo = ph; p.ph_hi = ph + 1; hipLaunchKernelGGL(mega_fwd, dim3(grid), dim3(512), LDS_BYTES, stream, p); }
#else
  p.ph_lo = 0; p.ph_hi = NPHASE;
  void* args[] = {&p};
  hipError_t e = hipLaunchCooperativeKernel((const void*)mega_fwd, dim3(grid), dim3(512), args, LDS_BYTES, stream);
  if (e != hipSuccess) fprintf(stderr, "cooperative launch failed: %s (grid %d)\n", hipGetErrorString(e), grid);
#endif
}
```

```cpp
#include <hip/hip_runtime.h>
#include <hip/hip_cooperative_groups.h>
#include <cstdio>
#include <cstdint>
namespace cg = cooperative_groups;

#ifndef MK_MULTI
#define MK_MULTI 0
#define MK_DUPMASK 0ull
#endif

typedef unsigned short bf16_t;
typedef short bf16x8_t __attribute__((ext_vector_type(8)));
typedef short s16x4_t __attribute__((ext_vector_type(4)));
typedef float f32x4_t __attribute__((ext_vector_type(4)));
typedef unsigned u32x4_t __attribute__((ext_vector_type(4)));
typedef _Float16 h16x4_t __attribute__((ext_vector_type(4)));

constexpr int DM = 1024, NB = 8, SEQ = 2048, CTXL = 256, TT = 2304, MR = NB * TT, DFF = 4096;
constexpr float EPS = 1e-6f;
constexpr size_t MiB = 1024ull * 1024ull;
constexpr size_t WS_XC = 0;
constexpr size_t WS_MOD = 8 * MiB;
constexpr size_t WS_S5A = 9 * MiB;
constexpr size_t WS_BAR = 10 * MiB + 512 * 1024;
constexpr size_t WS_DT = 11 * MiB;
constexpr size_t WS_WT = 16 * MiB;
constexpr size_t WT_W1 = WS_WT;
constexpr size_t WT_W2 = WT_W1 + 32 * MiB;
constexpr size_t WT_GQKV = WT_W2 + 32 * MiB;
constexpr size_t WT_GO = WT_GQKV + 3 * MiB;
constexpr size_t WT_GLU = WT_GO + 2 * MiB;
constexpr size_t WT_SIN1 = WT_GLU + 2 * MiB;
constexpr size_t WT_SGATE = WT_SIN1 + 13 * MiB / 2;
constexpr size_t WT_SOUT = WT_SGATE + 4 * MiB;
constexpr size_t WT_NQKV = WT_SOUT + 4 * MiB;
constexpr size_t WT_NO = WT_NQKV + 6 * MiB;
constexpr size_t WS_XB = WT_NO + 2 * MiB;
constexpr size_t WS_H = WS_XB;
constexpr size_t WS_BIG = WS_H + 36 * MiB;
constexpr size_t WS_S5T = WS_BIG + 225 * MiB;
constexpr size_t WS_END = WS_S5T + 9 * MiB;
constexpr int SSD_N1 = 3328;

__device__ __forceinline__ float bf2f(bf16_t v) { return __uint_as_float(((unsigned)v) << 16); }
__device__ __forceinline__ unsigned pk2(float lo, float hi);
__device__ __forceinline__ bf16_t f2bf(float f) { return (bf16_t)(pk2(f, f) & 0xffffu); }
__device__ __forceinline__ unsigned short f2bf_att(float f) { return f2bf(f); }
typedef __bf16 bf16v2_t __attribute__((ext_vector_type(2)));
typedef float f32v2_t __attribute__((ext_vector_type(2)));
__device__ __forceinline__ unsigned pk2(float lo, float hi) { const f32v2_t v = {lo, hi}; const bf16v2_t b = __builtin_convertvector(v, bf16v2_t); return __builtin_bit_cast(unsigned, b); }
__device__ __forceinline__ float wave_sum(float v) {
#pragma unroll
  for (int o = 32; o >= 1; o >>= 1) v += __shfl_xor(v, o);
  return v;
}
__device__ __forceinline__ void unpack8(uint4 v, float* f) {
  f[0] = __uint_as_float(v.x << 16); f[1] = __uint_as_float(v.x & 0xffff0000u);
  f[2] = __uint_as_float(v.y << 16); f[3] = __uint_as_float(v.y & 0xffff0000u);
  f[4] = __uint_as_float(v.z << 16); f[5] = __uint_as_float(v.z & 0xffff0000u);
  f[6] = __uint_as_float(v.w << 16); f[7] = __uint_as_float(v.w & 0xffff0000u);
}
__device__ __forceinline__ uint4 pack8(const float* f) {
  uint4 v; v.x = pk2(f[0], f[1]); v.y = pk2(f[2], f[3]); v.z = pk2(f[4], f[5]); v.w = pk2(f[6], f[7]); return v;
}
__device__ __forceinline__ float frcp(float x) { return __builtin_amdgcn_rcpf(x); }
__device__ __forceinline__ float silu_f(float x) { return x * frcp(1.0f + __expf(-x)); }

struct Params {
  const float* in[34];
  float* out;
  unsigned char* ws;
  int ph_lo, ph_hi;
};
namespace pg8 {
#define PG8_LAS __attribute__((address_space(3)))
typedef unsigned short bf16_t;
typedef short bf16x8 __attribute__((ext_vector_type(8)));
typedef float f32x4 __attribute__((ext_vector_type(4)));
typedef unsigned u32x4 __attribute__((ext_vector_type(4)));
constexpr int BM = 256, BK = 64, HALF = 128, HTB = HALF * BK * 2  , STAGE_BYTES = 8 * HTB, NXCD = 8, WGM = 8;

__host__ __device__ __forceinline__ int lds_byte(int r, int c) { const int st = (r >> 4) * 2 + (c >> 5), rr = r & 15, cc = c & 31, ob = rr * 64 + cc * 2; return st * 1024 + (ob ^ (((ob >> 9) & 1) << 5)); }
__host__ __device__ __forceinline__ void stage_rc(int b, int& R, int& C) { const int st = b / 1024, sb = b % 1024, swz = sb ^ (((sb >> 9) & 1) << 5); R = (st >> 1) * 16 + swz / 64; C = (st & 1) * 32 + (swz % 64) / 2; }
__host__ __device__ __forceinline__ int perm32(int rho) { const int n = rho >> 4, i = rho & 15; return 8 * (i >> 2) + 4 * n + (i & 3); }

struct Unit { int pm, pn; size_t ao, bo; };
struct Gemm { const bf16_t* A; const bf16_t* Bt; int M, N, K, lda, ldb; };

struct StaticOrder {
    int nM, nN, nwg, G, c, lda, ldb;
    __host__ __device__ void init(int M, int N, int G_, int c_, int lda_, int ldb_) { nM = M / BM; nN = N / BM; nwg = nM * nN; G = G_; c = c_; lda = lda_; ldb = ldb_; }
    __host__ __device__ bool next(int i, Unit& u) const {
        const long L = (long)i * G + c; if (L >= nwg) return false;
        int wgid = (int)L; { const int q = nwg / NXCD, r = nwg % NXCD, xcd = wgid % NXCD, off = wgid / NXCD; wgid = (xcd < r ? xcd * (q + 1) : r * (q + 1) + (xcd - r) * q) + off; }
        const int nig = WGM * nN, gid = wgid / nig, fm = gid * WGM, gsz = (nM - fm) < WGM ? (nM - fm) : WGM;
        u.pm = fm + ((wgid % nig) % gsz); u.pn = (wgid % nig) / gsz; u.ao = (size_t)u.pm * BM * lda * 2; u.bo = (size_t)u.pn * BM * ldb * 2; return true;
    }
    __device__ __forceinline__ void a_ready(const Unit&) const {}
    __device__ __forceinline__ void done(const Unit&) const {}
};

struct LatOrder {
    int nN, G, c, lda, ldb;
    __device__ void init(int N, int G_, int c_, int lda_, int ldb_) { nN = N / BM; G = G_; c = c_; lda = lda_; ldb = ldb_; }
    __device__ bool next(int i, Unit& u) const {
        const int x = c & 7, q = i * (G >> 3) + (c >> 3); if (q >= 8 * nN) return false;
        const int rt = x * 8 + (q & 7); u.pn = q >> 3; u.pm = (rt >> 3) * 9 + 1 + (rt & 7);
        u.ao = (size_t)u.pm * BM * lda * 2; u.bo = (size_t)u.pn * BM * ldb * 2; return true;
    }
    __device__ __forceinline__ void a_ready(const Unit&) const {}
    __device__ __forceinline__ void done(const Unit&) const {}
};
struct CtxSplitOrder {
    int nN, KS, Kp, G, c, lda, ldb;
    __device__ void init(int N, int KS_, int Kp_, int G_, int c_, int lda_, int ldb_) { nN = N / BM; KS = KS_; Kp = Kp_; G = G_; c = c_; lda = lda_; ldb = ldb_; }
    __device__ bool next(int i, Unit& u) const {
        if (i > 0) return false;
        const int x = c & 7, j = c >> 3, ks = x % KS, idx = (x / KS) * (G >> 3) + j; if (idx >= 8 * nN) return false;
        const int b = idx & 7, pn = idx >> 3;
        u.pm = b; u.pn = ks * nN + pn;
        u.ao = ((size_t)(b * 9) * BM * lda + (size_t)ks * Kp) * 2; u.bo = ((size_t)pn * BM * ldb + (size_t)ks * Kp) * 2; return true;
    }
    __device__ __forceinline__ void a_ready(const Unit&) const {}
    __device__ __forceinline__ void done(const Unit&) const {}
};
__device__ __forceinline__ unsigned cvt_pk_bf16(float lo, float hi) { unsigned r; asm volatile("v_cvt_pk_bf16_f32 %0, %1, %2" : "=v"(r) : "v"(lo), "v"(hi)); return r; }
typedef float f32x2 __attribute__((ext_vector_type(2)));
template <int ACT> struct EpiB {
    static constexpr bool PERM = true, AFTER_DRAIN = false;
    bf16_t* O; int ldc; const float* bias; const bf16_t* aux;
    __device__ __forceinline__ void operator()(const f32x4 (&acc)[2][2][4][2], const Unit& u, int wr, int wc, int fr, int fq) const {
        const int row0 = u.pm * BM + wr * 64 + fr; const int col0 = u.pn * BM + wc * 32 + 8 * fq;
#pragma unroll
        for (int ai = 0; ai < 2; ++ai)
#pragma unroll
            for (int m = 0; m < 4; ++m) { const size_t roff = (size_t)(row0 + ai * HALF + m * 16) * ldc + col0;
#pragma unroll
                for (int bj = 0; bj < 2; ++bj) { f32x4 v0 = acc[ai][bj][m][0], v1 = acc[ai][bj][m][1];
                    if (ACT == 1) {
#pragma unroll
                        for (int j = 0; j < 4; ++j) { float a = v0[j] > 0.f ? v0[j] : 0.f; v0[j] = a * a; float b = v1[j] > 0.f ? v1[j] : 0.f; v1[j] = b * b; } }
                    if (ACT == 2) {
                        const f32x4 b0 = *(const f32x4*)(bias + col0 + bj * HALF), b1 = *(const f32x4*)(bias + col0 + bj * HALF + 4);
                        const u32x4 g = *(const u32x4*)(aux + roff + bj * HALF);
                        float gf[8]; gf[0] = __uint_as_float(g.x << 16); gf[1] = __uint_as_float(g.x & 0xffff0000u); gf[2] = __uint_as_float(g.y << 16); gf[3] = __uint_as_float(g.y & 0xffff0000u);
                        gf[4] = __uint_as_float(g.z << 16); gf[5] = __uint_as_float(g.z & 0xffff0000u); gf[6] = __uint_as_float(g.w << 16); gf[7] = __uint_as_float(g.w & 0xffff0000u);
#pragma unroll
                        for (int j = 0; j < 4; ++j) { v0[j] = gf[j] * ::frcp(1.0f + __expf(-(v0[j] + b0[j]))); v1[j] = gf[4 + j] * ::frcp(1.0f + __expf(-(v1[j] + b1[j]))); } }
                    u32x4 w; w.x = ::pk2(v0[0], v0[1]); w.y = ::pk2(v0[2], v0[3]); w.z = ::pk2(v1[0], v1[1]); w.w = ::pk2(v1[2], v1[3]);
                    *(u32x4*)(O + roff + bj * HALF) = w; } }
    }
};
template <class Epi, class Sched, bool STAMP = false>
__device__ __forceinline__ void gemm_phase(PG8_LAS unsigned char* lds, const Gemm g, const Sched& S, const Epi& E, unsigned long long* stamps) {
    const int tid = threadIdx.x, wid = __builtin_amdgcn_readfirstlane(tid >> 6), lane = tid & 63, wr = wid >> 2, wc = wid & 3, fr = lane & 15, fq = lane >> 4;
    const int K = g.K, nt = K / BK;
    int ts_lo = 0, ts_hi = 0, nts = 0; const unsigned long long rt_entry = STAMP ? (unsigned long long)wall_clock64() : 0ull;
#define PG8_STAMP() do { if (STAMP && wid == 0 && nts < 64) { const unsigned long long _c = (unsigned long long)clock64(); \
        ts_lo = (lane == nts) ? (int)(unsigned)_c : ts_lo; ts_hi = (lane == nts) ? (int)(unsigned)(_c >> 32) : ts_hi; ++nts; } } while (0)
    PG8_STAMP();
    unsigned voffA[2], voffB[2];
#pragma unroll
    for (int i = 0; i < 2; ++i) { int R, C; stage_rc(tid * 16 + i * 8192, R, C); const int Rb = Epi::PERM ? ((R & ~31) + perm32(R & 31)) : R;
        voffA[i] = (unsigned)(R * g.lda + C) * 2u; voffB[i] = (unsigned)(Rb * g.ldb + C) * 2u; }
    const size_t kstep = (size_t)(BK * 2);
    const size_t hstepA = (size_t)HALF * g.lda * 2, hstepB = (size_t)HALF * g.ldb * 2;
    const unsigned ldsw = (unsigned)wid * 1024u;
    const int aoff = lds_byte(wr * 64 + fr, fq * 8), boff = lds_byte(wc * 32 + fr, fq * 8);
#define PG8_SA(b, h) (((b) * 2 + (h)) * HTB)
#define PG8_SB(b, h) ((4 + (b) * 2 + (h)) * HTB)
#define PG8_STAGE(bufoff, gbase, voff) do { _Pragma("unroll") for (int _i = 0; _i < 2; ++_i) \
        __builtin_amdgcn_global_load_lds((const unsigned*)((const char*)(gbase) + (voff)[_i]), (PG8_LAS unsigned*)(lds + (bufoff) + ldsw + _i * 8192), 16, 0, 0); } while (0)
#define PG8_LDA(dst, b, h) do { _Pragma("unroll") for (int m = 0; m < 4; ++m) _Pragma("unroll") for (int k = 0; k < 2; ++k) dst[m][k] = *(const PG8_LAS bf16x8*)(lds + PG8_SA(b, h) + aoff + m * 2048 + k * 1024); } while (0)
#define PG8_LDB(dst, b, h) do { _Pragma("unroll") for (int n = 0; n < 2; ++n) _Pragma("unroll") for (int k = 0; k < 2; ++k) dst[n][k] = *(const PG8_LAS bf16x8*)(lds + PG8_SB(b, h) + boff + n * 2048 + k * 1024); } while (0)
#define PG8_MMA(ai, bj, At, Bt) do { __builtin_amdgcn_s_setprio(1); _Pragma("unroll") for (int m = 0; m < 4; ++m) _Pragma("unroll") for (int n = 0; n < 2; ++n) _Pragma("unroll") for (int k = 0; k < 2; ++k) \
        acc[ai][bj][m][n] = __builtin_amdgcn_mfma_f32_16x16x32_bf16(Bt[n][k], At[m][k], acc[ai][bj][m][n], 0, 0, 0); __builtin_amdgcn_s_setprio(0); } while (0)
#define PG8_WAIT_V(n) asm volatile("s_waitcnt vmcnt(" #n ")" ::: "memory")
#define PG8_WAIT_L(n) asm volatile("s_waitcnt lgkmcnt(" #n ")" ::: "memory")
#define PG8_BAR __builtin_amdgcn_s_barrier()
#define PG8_SCHED __builtin_amdgcn_sched_barrier(0)
    Unit cur, nxt; int ui = 0;
    if (!S.next(0, cur)) return;
    f32x4 acc[2][2][4][2];
#pragma unroll
    for (int a = 0; a < 2; ++a)
#pragma unroll
        for (int b = 0; b < 2; ++b)
#pragma unroll
            for (int m = 0; m < 4; ++m)
#pragma unroll
                for (int n = 0; n < 2; ++n) acc[a][b][m][n] = (f32x4){0.f, 0.f, 0.f, 0.f};
    bf16x8 At[4][2], B0[2][2], B1[2][2];
    const char* cA = (const char*)g.A + cur.ao; const char* cB = (const char*)g.Bt + cur.bo;
    S.a_ready(cur);
    PG8_STAGE(PG8_SB(0, 0), cB, voffB); PG8_STAGE(PG8_SA(0, 0), cA, voffA); PG8_STAGE(PG8_SB(0, 1), cB + hstepB, voffB); PG8_STAGE(PG8_SA(0, 1), cA + hstepA, voffA);
    if (wr == 1) PG8_BAR;
    PG8_WAIT_V(4); PG8_BAR;
    PG8_STAGE(PG8_SB(1, 0), cB + kstep, voffB); PG8_STAGE(PG8_SA(1, 0), cA + kstep, voffA); PG8_STAGE(PG8_SB(1, 1), cB + hstepB + kstep, voffB);
    PG8_WAIT_V(6); PG8_BAR;
    PG8_STAMP();
    for (;;) {
        const bool has_next = S.next(ui + 1, nxt);
        const char* nA = has_next ? (const char*)g.A + nxt.ao : cA; const char* nB = has_next ? (const char*)g.Bt + nxt.bo : cB;
        for (int t = 0; t < nt; t += 2) {
            const bool last = (t == nt - 2);
            const char* a1 = cA + (size_t)(t + 1) * kstep;
            const char* a2 = last ? nA : cA + (size_t)(t + 2) * kstep; const char* b2 = last ? nB : cB + (size_t)(t + 2) * kstep;
            const char* a3 = a2 + kstep; const char* b3 = b2 + kstep;
            if (last && has_next) S.a_ready(nxt);
            PG8_LDB(B0, 0, 0); PG8_SCHED; PG8_LDA(At, 0, 0); PG8_STAGE(PG8_SA(1, 1), a1 + hstepA, voffA);
            PG8_WAIT_L(8); PG8_BAR; PG8_WAIT_L(0); PG8_MMA(0, 0, At, B0); PG8_BAR; PG8_SCHED;
            PG8_LDB(B1, 0, 1); PG8_STAGE(PG8_SB(0, 0), b2, voffB);
            PG8_BAR; PG8_WAIT_L(0); PG8_MMA(0, 1, At, B1); PG8_BAR;
            PG8_LDA(At, 0, 1); PG8_STAGE(PG8_SA(0, 0), a2, voffA);
            PG8_BAR; PG8_WAIT_L(0); PG8_MMA(1, 0, At, B0); PG8_BAR; PG8_SCHED;
            PG8_STAGE(PG8_SB(0, 1), b2 + hstepB, voffB);
            PG8_WAIT_V(6); PG8_BAR; PG8_MMA(1, 1, At, B1); PG8_BAR;
            PG8_LDB(B0, 1, 0); PG8_SCHED; PG8_LDA(At, 1, 0); PG8_STAGE(PG8_SA(0, 1), a2 + hstepA, voffA);
            PG8_WAIT_L(8); PG8_BAR; PG8_WAIT_L(0); PG8_MMA(0, 0, At, B0); PG8_BAR; PG8_SCHED;
            PG8_LDB(B1, 1, 1); PG8_STAGE(PG8_SB(1, 0), b3, voffB);
            PG8_BAR; PG8_WAIT_L(0); PG8_MMA(0, 1, At, B1); PG8_BAR;
            PG8_LDA(At, 1, 1); PG8_STAGE(PG8_SA(1, 0), a3, voffA);
            PG8_BAR; PG8_WAIT_L(0); PG8_MMA(1, 0, At, B0); PG8_BAR; PG8_SCHED;
            PG8_STAGE(PG8_SB(1, 1), b3 + hstepB, voffB);
            PG8_WAIT_V(6); PG8_BAR; PG8_MMA(1, 1, At, B1); PG8_BAR;
        }
        PG8_STAMP();
        if constexpr (!Epi::AFTER_DRAIN) { E(acc, cur, wr, wc, fr, fq); S.done(cur); }
        PG8_STAMP();
        if (!has_next) break;
#pragma unroll
        for (int a = 0; a < 2; ++a)
#pragma unroll
            for (int b = 0; b < 2; ++b)
#pragma unroll
                for (int m = 0; m < 4; ++m)
#pragma unroll
                    for (int n = 0; n < 2; ++n) acc[a][b][m][n] = (f32x4){0.f, 0.f, 0.f, 0.f};
        cur = nxt; cA = nA; cB = nB; ++ui;
    }
    PG8_WAIT_V(0);
    if (wr == 0) PG8_BAR;
    PG8_BAR;
    if constexpr (Epi::AFTER_DRAIN) { E.fused(acc, cur, wr, wc, fr, fq, lds, wid, lane); S.done(cur); }
    PG8_STAMP();
    if (STAMP && wid == 0) { stamps[lane] = lane < nts ? (((unsigned long long)(unsigned)ts_hi << 32) | (unsigned)ts_lo) : 0ull;
        if (lane == 62) stamps[62] = rt_entry; if (lane == 63) stamps[63] = (unsigned long long)wall_clock64(); }
#undef PG8_STAMP
#undef PG8_SA
#undef PG8_SB
#undef PG8_STAGE
#undef PG8_LDA
#undef PG8_LDB
#undef PG8_MMA
#undef PG8_WAIT_V
#undef PG8_WAIT_L
#undef PG8_BAR
#undef PG8_SCHED
}
}
namespace att {
using bf16 = unsigned short;
constexpr int   D = 128, NW = 8, QBLK = 32, KVBLK = 64;
constexpr float SCALE = 0.088388347648318440f;
constexpr float THR = 8.f;
constexpr int SDEPTH = 2;
constexpr int LDQ = 1536, LDK = 1536, LDO = 1024;
constexpr size_t SHM_V = KVBLK * D * 2, SHM_K = KVBLK * D * 2, SHM_ATTN = 2 * SHM_V + 2 * SHM_K + NW * 64 * 4;
using bf16x8 = __attribute__((ext_vector_type(8))) short;
using s16x4  = __attribute__((ext_vector_type(4))) short;
using f32x16 = __attribute__((ext_vector_type(16))) float;
using f32x8  = __attribute__((ext_vector_type(8))) float;
using u32x4  = __attribute__((ext_vector_type(4))) unsigned;
#define KSWZ(row, colB) ((row) * 256 + ((colB) ^ (((row) & 7) << 4)))
#define SBAR() __builtin_amdgcn_sched_barrier(0)
__device__ __forceinline__ int crow(int r, int hi) { return (r & 3) + 8 * (r >> 2) + 4 * hi; }
__device__ __forceinline__ unsigned cvtpk(float lo, float hi) {
  unsigned r; asm volatile("v_cvt_pk_bf16_f32 %0, %1, %2" : "=v"(r) : "v"(lo), "v"(hi)); return r;
}
template <typename TIn> struct Stage;
template <> struct Stage<bf16>  { using T = bf16x8;
  __device__ static __forceinline__ T ld8(const bf16* p) { return *reinterpret_cast<const bf16x8*>(p); }
  __device__ static __forceinline__ bf16x8 tobf(T x) { return x; } };
template <> struct Stage<float> { using T = f32x8;
  __device__ static __forceinline__ T ld8(const float* p) { return *reinterpret_cast<const f32x8*>(p); }
  __device__ static __forceinline__ bf16x8 tobf(T x) {
    u32x4 w = {cvtpk(x[0], x[1]), cvtpk(x[2], x[3]), cvtpk(x[4], x[5]), cvtpk(x[6], x[7])}; return *reinterpret_cast<bf16x8*>(&w); } };

__device__ __forceinline__ void partialSM(f32x16& p0, f32x16& p1, float& m_reg, float& mn, float& alpha) {
  constexpr float C = SCALE * 1.4426950408889634f;
  float pmax = p0[0]; for (int r = 1; r < 16; ++r) pmax = fmaxf(pmax, p0[r]); for (int r = 0; r < 16; ++r) pmax = fmaxf(pmax, p1[r]);
  { auto rr = __builtin_amdgcn_permlane32_swap(__float_as_uint(pmax), __float_as_uint(pmax), false, false);
    pmax = fmaxf(__uint_as_float(rr[0]), __uint_as_float(rr[1])); }
  if (__builtin_expect(__all(pmax - m_reg <= THR / SCALE), 1)) { mn = m_reg; alpha = 1.f; }
  else { mn = fmaxf(m_reg, pmax); alpha = __builtin_amdgcn_exp2f((m_reg - mn) * C); m_reg = mn; }
  float mnC = -mn * C;
  for (int r = 0; r < 16; ++r) p0[r] = fmaf(p0[r], C, mnC); for (int r = 0; r < 16; ++r) p1[r] = fmaf(p1[r], C, mnC);
  for (int r = 0; r < 16; ++r) p0[r] = __builtin_amdgcn_exp2f(p0[r]);
}
__device__ __forceinline__ void finishSM(f32x16& p0, f32x16& p1, float alpha, float& l_reg, bf16x8& pa0, bf16x8& pa1, bf16x8& pa2, bf16x8& pa3) {
  for (int r = 0; r < 16; ++r) p1[r] = __builtin_amdgcn_exp2f(p1[r]);
  float ps = 0; for (int r = 0; r < 16; ++r) ps += p0[r]; for (int r = 0; r < 16; ++r) ps += p1[r];
  { auto rr = __builtin_amdgcn_permlane32_swap(__float_as_uint(ps), __float_as_uint(ps), false, false);
    ps = __uint_as_float(rr[0]) + __uint_as_float(rr[1]); }
  l_reg = l_reg * alpha + ps;
#define PK4(P, BASE, OUT) do { unsigned a0 = cvtpk(P[BASE + 0], P[BASE + 1]), a1 = cvtpk(P[BASE + 2], P[BASE + 3]);   \
    unsigned b0 = cvtpk(P[BASE + 4], P[BASE + 5]), b1 = cvtpk(P[BASE + 6], P[BASE + 7]);                              \
    auto r0 = __builtin_amdgcn_permlane32_swap(a0, b0, false, false); auto r1 = __builtin_amdgcn_permlane32_swap(a1, b1, false, false); \
    u32x4 w = {r0[0], r1[0], r0[1], r1[1]}; OUT = *reinterpret_cast<bf16x8*>(&w); } while (0)
  PK4(p0, 0, pa0); PK4(p0, 8, pa1); PK4(p1, 0, pa2); PK4(p1, 8, pa3);
#undef PK4
}
__device__ __forceinline__ void qkt(f32x16& p0, f32x16& p1, const bf16* Ks, const bf16x8* qr, int r32, int hi) {
  p0 = f32x16{}; p1 = f32x16{};
  for (int d0 = 0; d0 < 8; ++d0) { int cb = (d0 * 16 + hi * 8) * 2;
    bf16x8 b0 = *reinterpret_cast<const bf16x8*>((const char*)Ks + KSWZ(r32, cb));
    bf16x8 b1 = *reinterpret_cast<const bf16x8*>((const char*)Ks + KSWZ(32 + r32, cb));
    p0 = __builtin_amdgcn_mfma_f32_32x32x16_bf16(b0, qr[d0], p0, 0, 0, 0);
    p1 = __builtin_amdgcn_mfma_f32_32x32x16_bf16(b1, qr[d0], p1, 0, 0, 0); }
}
__device__ __forceinline__ int v_st(int k, int c) { const int kk = (k & ~0xC) | ((k & 4) << 1) | ((k & 8) >> 1); return ((kk >> 3) * 4 + (c >> 5)) * 512 + ((kk & 7) * 32 + (c & 31)) * 2; }
__device__ __forceinline__ int v_rd_base(int lane) { return ((lane & 3) << 3) | (((lane >> 2) & 3) << 6) | (((lane >> 4) & 1) << 5) | (((lane >> 5) & 1) << 8); }
constexpr int v_rd_off(int d0, int ks, int half) { return d0 * 512 + ks * 4096 + half * 2048; }
template <int OFF> __device__ __forceinline__ s16x4 tr_read(int vb) {
  s16x4 r; asm volatile("ds_read_b64_tr_b16 %0, %1 offset:%2" : "=&v"(r) : "v"(vb), "i"(OFF) : "memory"); return r;
}
template <int D0> __device__ __forceinline__ void pv_one(f32x16& od, int vb, bf16x8 pa0, bf16x8 pa1, bf16x8 pa2, bf16x8 pa3) {
  const s16x4 l0 = tr_read<v_rd_off(D0, 0, 0)>(vb), h0 = tr_read<v_rd_off(D0, 0, 1)>(vb), l1 = tr_read<v_rd_off(D0, 1, 0)>(vb), h1 = tr_read<v_rd_off(D0, 1, 1)>(vb);
  const s16x4 l2 = tr_read<v_rd_off(D0, 2, 0)>(vb), h2 = tr_read<v_rd_off(D0, 2, 1)>(vb), l3 = tr_read<v_rd_off(D0, 3, 0)>(vb), h3 = tr_read<v_rd_off(D0, 3, 1)>(vb);
  asm volatile("s_waitcnt lgkmcnt(0)" ::: "memory"); SBAR();
#define PK(L, H) (bf16x8){L[0], L[1], L[2], L[3], H[0], H[1], H[2], H[3]}
  od = __builtin_amdgcn_mfma_f32_32x32x16_bf16(pa0, PK(l0, h0), od, 0, 0, 0);
  od = __builtin_amdgcn_mfma_f32_32x32x16_bf16(pa1, PK(l1, h1), od, 0, 0, 0);
  od = __builtin_amdgcn_mfma_f32_32x32x16_bf16(pa2, PK(l2, h2), od, 0, 0, 0);
  od = __builtin_amdgcn_mfma_f32_32x32x16_bf16(pa3, PK(l3, h3), od, 0, 0, 0);
#undef PK
}
__device__ __forceinline__ void pv_d0(f32x16* o, int vb, bf16x8 pa0, bf16x8 pa1, bf16x8 pa2, bf16x8 pa3) {
  pv_one<0>(o[0], vb, pa0, pa1, pa2, pa3); pv_one<1>(o[1], vb, pa0, pa1, pa2, pa3); pv_one<2>(o[2], vb, pa0, pa1, pa2, pa3); pv_one<3>(o[3], vb, pa0, pa1, pa2, pa3);
}

template <typename TQ>
__device__ __forceinline__ void attn_dense_body(const TQ* __restrict__ Qb, const bf16* __restrict__ Kh, const bf16* __restrict__ Vh,
                                                unsigned short* __restrict__ Ob, int seq, char* lds) {
  using St = Stage<bf16>; using SQ = Stage<TQ>;
  const int tid = threadIdx.x, wid = tid >> 6, lane = tid & 63, r32 = lane & 31, hi = lane >> 5;
  bf16* V_lds = (bf16*)lds; bf16* K_lds = (bf16*)(lds + 2 * SHM_V);
  float* ws = (float*)(lds + 2 * SHM_V + 2 * SHM_K) + wid * 64; float* li_l = ws; float* al_l = ws + 32;
  float m_reg = -1e30f, l_reg = 0; f32x16 o[4] = {}; bf16x8 qr[8];
  const TQ* Qw = Qb + (long)(wid * QBLK + r32) * LDQ + hi * 8;
#pragma unroll
  for (int d0 = 0; d0 < 8; ++d0) qr[d0] = SQ::tobf(SQ::ld8(Qw + d0 * 16));
  const int sr = tid >> 4, sc = (tid & 15) * 8, vst0 = v_st(sr, sc), vst1 = v_st(32 + sr, sc);
  const int vb0 = (int)(uintptr_t)V_lds + v_rd_base(lane);
  struct { typename St::T vs0, vs1, ks0, ks1; } sr_[SDEPTH];
#define SLOAD(i, k0) do { sr_[i].vs0 = St::ld8(&Vh[(long)((k0) + sr) * LDK + sc]); sr_[i].vs1 = St::ld8(&Vh[(long)((k0) + 32 + sr) * LDK + sc]); \
    sr_[i].ks0 = St::ld8(&Kh[(long)((k0) + sr) * LDK + sc]); sr_[i].ks1 = St::ld8(&Kh[(long)((k0) + 32 + sr) * LDK + sc]); } while (0)
#define SWRITE(b, i) do { *(bf16x8*)((char*)V_lds + (b) * SHM_V + vst0) = St::tobf(sr_[i].vs0);          \
    *(bf16x8*)((char*)V_lds + (b) * SHM_V + vst1) = St::tobf(sr_[i].vs1); int kc = sc * 2;               \
    *(bf16x8*)((char*)K_lds + (b) * SHM_K + KSWZ(sr, kc)) = St::tobf(sr_[i].ks0);                       \
    *(bf16x8*)((char*)K_lds + (b) * SHM_K + KSWZ(32 + sr, kc)) = St::tobf(sr_[i].ks1); } while (0)
#define SWAIT() do { if constexpr (SDEPTH == 2) asm volatile("s_waitcnt vmcnt(4)" ::: "memory"); else asm volatile("s_waitcnt vmcnt(0)" ::: "memory"); } while (0)
#define RESC(a) do { if (__any((a) < 1.f)) { if (hi == 0) al_l[r32] = (a); asm volatile("s_waitcnt lgkmcnt(0)" ::: "memory"); \
    for (int d = 0; d < 4; ++d) for (int r = 0; r < 16; ++r) o[d][r] *= al_l[crow(r, hi)]; } } while (0)
  f32x16 pA0, pA1, pB0, pB1; float mnA, mnB, alA, alB; bf16x8 pa0, pa1, pa2, pa3; const int NT = seq / KVBLK;
  constexpr int SE = 0, SO = SDEPTH - 1;
  SLOAD(SE, 0); asm volatile("s_waitcnt vmcnt(0)" ::: "memory"); SWRITE(0, SE); __syncthreads();
  qkt(pA0, pA1, K_lds, qr, r32, hi); partialSM(pA0, pA1, m_reg, mnA, alA);
  SLOAD(SO, KVBLK); if constexpr (SDEPTH == 2) { if (2 < NT) SLOAD(SE, 2 * KVBLK); }
  SWAIT(); SWRITE(1, SO); __syncthreads();
  for (int j = 1; j + 1 < NT; j += 2) {
    SBAR(); qkt(pB0, pB1, (bf16*)((char*)K_lds + SHM_K), qr, r32, hi);
    finishSM(pA0, pA1, alA, l_reg, pa0, pa1, pa2, pa3); SBAR();
    SLOAD(SO, (j + SDEPTH) * KVBLK); SBAR();
    pv_d0(o, vb0, pa0, pa1, pa2, pa3); partialSM(pB0, pB1, m_reg, mnB, alB);
    __syncthreads(); SWAIT(); SWRITE(0, SE);
    RESC(alB); __syncthreads();
    SBAR(); qkt(pA0, pA1, K_lds, qr, r32, hi);
    finishSM(pB0, pB1, alB, l_reg, pa0, pa1, pa2, pa3); SBAR();
    if (SDEPTH == 1 || j + 3 < NT) SLOAD(SE, (j + 1 + SDEPTH) * KVBLK); SBAR();
    pv_d0(o, vb0 + (int)SHM_V, pa0, pa1, pa2, pa3); partialSM(pA0, pA1, m_reg, mnA, alA);
    __syncthreads(); SWAIT(); SWRITE(1, SO);
    RESC(alA); __syncthreads();
  }
  SBAR(); qkt(pB0, pB1, (bf16*)((char*)K_lds + SHM_K), qr, r32, hi);
  finishSM(pA0, pA1, alA, l_reg, pa0, pa1, pa2, pa3); SBAR();
  pv_d0(o, vb0, pa0, pa1, pa2, pa3); partialSM(pB0, pB1, m_reg, mnB, alB);
  __syncthreads(); RESC(alB);
  finishSM(pB0, pB1, alB, l_reg, pa0, pa1, pa2, pa3); SBAR();
  pv_d0(o, vb0 + (int)SHM_V, pa0, pa1, pa2, pa3);
  if (hi == 0) li_l[r32] = l_reg; asm volatile("s_waitcnt lgkmcnt(0)" ::: "memory");
  float rli[16];
#pragma unroll
  for (int r = 0; r < 16; ++r) rli[r] = __builtin_amdgcn_rcpf(li_l[crow(r, hi)]);
  unsigned short* Ow = Ob + (long)(wid * QBLK) * LDO;
#pragma unroll
  for (int r = 0; r < 16; ++r) { int orow = crow(r, hi);
    for (int d0 = 0; d0 < 4; ++d0) Ow[(long)orow * LDO + d0 * 32 + r32] = f2bf_att(o[d0][r] * rli[r]); }
#undef SLOAD
#undef SWRITE
#undef SWAIT
#undef RESC
}
}

#define MFMA16(a, b, c) __builtin_amdgcn_mfma_f32_16x16x32_bf16((a), (b), (c), 0, 0, 0)
#define LDS_BAR() do { asm volatile("s_waitcnt lgkmcnt(0)" ::: "memory"); __builtin_amdgcn_s_barrier(); asm volatile("" ::: "memory"); } while (0)

__device__ __forceinline__ bf16x8_t tr_frag(const void* base, int rs, int k0, int n0, int lane) {
  const int g = lane >> 4, qq = (lane & 15) >> 2, pp = lane & 3;
  const unsigned a0 = (unsigned)(uintptr_t)base + (unsigned)((k0 + 8 * g + qq) * rs + (n0 + 4 * pp) * 2);
  const unsigned a1 = a0 + 4u * (unsigned)rs;
  s16x4_t lo, hi;
  asm volatile("ds_read_b64_tr_b16 %0, %2\n\tds_read_b64_tr_b16 %1, %3\n\ts_waitcnt lgkmcnt(0)" : "=&v"(lo), "=&v"(hi) : "v"(a0), "v"(a1) : "memory");
  return (bf16x8_t){lo[0], lo[1], lo[2], lo[3], hi[0], hi[1], hi[2], hi[3]};
}

__device__ __forceinline__ float4 ntload4(const float* ptr) { const f32x4_t v = __builtin_nontemporal_load((const f32x4_t*)ptr); return make_float4(v[0], v[1], v[2], v[3]); }

struct WJob { const float* src; int ld, col0, K, N, Npad; bf16_t* dst; };
__device__ __forceinline__ WJob get_wjob(const Params& p, int j) {
  unsigned char* ws = p.ws; WJob w;
  if (j < 4)       { w.src = p.in[7] + (size_t)j * DM * DFF; w.ld = DFF; w.col0 = 0; w.K = DM; w.N = DFF; w.Npad = DFF; w.dst = (bf16_t*)(ws + WT_W1) + (size_t)j * DM * DFF; }
  else if (j < 8)  { w.src = p.in[8] + (size_t)(j - 4) * DM * DFF; w.ld = DM; w.col0 = 0; w.K = DFF; w.N = DM; w.Npad = DM; w.dst = (bf16_t*)(ws + WT_W2) + (size_t)(j - 4) * DM * DFF; }
  else if (j == 8) { w.src = p.in[9]; w.ld = 1536; w.col0 = 0; w.K = DM; w.N = 1536; w.Npad = 1536; w.dst = (bf16_t*)(ws + WT_GQKV); }
  else if (j == 9) { w.src = p.in[12]; w.ld = DM; w.col0 = 0; w.K = DM; w.N = DM; w.Npad = DM; w.dst = (bf16_t*)(ws + WT_GO); }
  else if (j == 10){ w.src = p.in[21]; w.ld = DM; w.col0 = 0; w.K = DM; w.N = DM; w.Npad = DM; w.dst = (bf16_t*)(ws + WT_GLU); }
  else if (j == 11){ w.src = p.in[23]; w.ld = 5184; w.col0 = 2048; w.K = DM; w.N = 3136; w.Npad = SSD_N1; w.dst = (bf16_t*)(ws + WT_SIN1); }
  else if (j == 12){ w.src = p.in[23]; w.ld = 5184; w.col0 = 0; w.K = DM; w.N = 2048; w.Npad = 2048; w.dst = (bf16_t*)(ws + WT_SGATE); }
  else if (j == 13){ w.src = p.in[30]; w.ld = DM; w.col0 = 0; w.K = 2048; w.N = DM; w.Npad = DM; w.dst = (bf16_t*)(ws + WT_SOUT); }
  else if (j == 14){ w.src = p.in[31]; w.ld = 3072; w.col0 = 0; w.K = DM; w.N = 3072; w.Npad = 3072; w.dst = (bf16_t*)(ws + WT_NQKV); }
  else             { w.src = p.in[33]; w.ld = DM; w.col0 = 0; w.K = DM; w.N = DM; w.Npad = DM; w.dst = (bf16_t*)(ws + WT_NO); }
  return w;
}

__device__ __forceinline__ void phase_prep(const Params& p, unsigned char* lds) {
  const int tid = threadIdx.x, lane = tid & 63, wid = tid >> 6;
  float* tile = (float*)lds;
  for (int j = 0; j < 16; ++j) {
    const WJob w = get_wjob(p, j);
    const int tn = w.Npad / 64, tk = w.K / 64, nt = tn * tk;
    const int kk0 = tid >> 4, nn4 = (tid & 15) * 4;
    float4 v0 = make_float4(0.f, 0.f, 0.f, 0.f), v1 = v0;
    int t = blockIdx.x;
    if (t < nt) { const int n0 = (t % tn) * 64, k0 = (t / tn) * 64;
      if (n0 < w.N) { v0 = ntload4(w.src + (size_t)(k0 + kk0) * w.ld + w.col0 + n0 + nn4); v1 = ntload4(w.src + (size_t)(k0 + kk0 + 32) * w.ld + w.col0 + n0 + nn4); } }
    for (; t < nt; t += gridDim.x) {
      const int n0 = (t % tn) * 64, k0 = (t / tn) * 64;
      tile[kk0 * 65 + nn4 + 0] = v0.x; tile[kk0 * 65 + nn4 + 1] = v0.y; tile[kk0 * 65 + nn4 + 2] = v0.z; tile[kk0 * 65 + nn4 + 3] = v0.w;
      tile[(kk0 + 32) * 65 + nn4 + 0] = v1.x; tile[(kk0 + 32) * 65 + nn4 + 1] = v1.y; tile[(kk0 + 32) * 65 + nn4 + 2] = v1.z; tile[(kk0 + 32) * 65 + nn4 + 3] = v1.w;
      __syncthreads();
      { const int t2 = t + gridDim.x; v0 = make_float4(0.f, 0.f, 0.f, 0.f); v1 = v0;
        if (t2 < nt) { const int n2 = (t2 % tn) * 64, k2 = (t2 / tn) * 64;
          if (n2 < w.N) { v0 = ntload4(w.src + (size_t)(k2 + kk0) * w.ld + w.col0 + n2 + nn4); v1 = ntload4(w.src + (size_t)(k2 + kk0 + 32) * w.ld + w.col0 + n2 + nn4); } } }
      { const int nn = tid >> 3, kk8 = (tid & 7) * 8; float f[8];
#pragma unroll
        for (int q = 0; q < 8; ++q) f[q] = tile[(kk8 + q) * 65 + nn];
        *(uint4*)(w.dst + (size_t)(n0 + nn) * w.K + k0 + kk8) = pack8(f); }
      __syncthreads();
    }
  }
  float* sc = (float*)lds;
  float* red = sc + 9 * 1024;
  const float* c = p.in[1]; const float* cc = p.in[3]; const float* ada_w = p.in[4]; const float* ada_b = p.in[5];
  float* MOD = (float*)(p.ws + WS_MOD);
  __syncthreads();
  for (int i = tid; i < 9 * 1024; i += 512) { const float v = (i < 8192) ? c[i] : cc[i - 8192]; sc[i] = v / (1.0f + expf(-v)); }
  __syncthreads();
  for (int t = blockIdx.x; t < 384; t += gridDim.x) {
    const int l = t / 96, n0 = (t % 96) * 64;
    const float* W = ada_w + (size_t)l * DM * 6144 + n0 + lane;
    float acc[9];
#pragma unroll
    for (int b = 0; b < 9; ++b) acc[b] = 0.f;
    const int kb = wid * 128;
#pragma unroll 32
    for (int k = kb; k < kb + 128; ++k) { const float wv = __builtin_nontemporal_load(W + (size_t)k * 6144);
#pragma unroll
      for (int b = 0; b < 9; ++b) acc[b] += sc[b * 1024 + k] * wv; }
#pragma unroll
    for (int b = 0; b < 9; ++b) red[(wid * 9 + b) * 64 + lane] = acc[b];
    __syncthreads();
    for (int i = tid; i < 9 * 64; i += 512) { const int b = i >> 6, ln = i & 63; float s = 0.f;
#pragma unroll
      for (int w8 = 0; w8 < 8; ++w8) s += red[(w8 * 9 + b) * 64 + ln];
      MOD[((size_t)l * 9 + b) * 6144 + n0 + ln] = s + ada_b[(size_t)l * 6144 + n0 + ln]; }
    __syncthreads();
  }
  {
    const float* a_re = p.in[13]; const float* a_im = p.in[14]; const float* log_dt = p.in[15]; const float* b_re = p.in[16]; const float* b_im = p.in[17];
    float2* ABAR = (float2*)(p.ws + WS_S5A); float2* AT = ABAR + 8192; float2* BBAR = AT + 8192;
    for (int idx = blockIdx.x * 512 + tid; idx < 8192; idx += gridDim.x * 512) {
      const int dg = idx >> 6;
      const double lr = (double)a_re[idx], li = (double)a_im[idx], dt = exp((double)log_dt[dg]);
      const double er = exp(lr * dt), ar = er * cos(li * dt), ai = er * sin(li * dt);
      const double e64 = exp(lr * dt * 64.0), tr = e64 * cos(li * dt * 64.0), ti = e64 * sin(li * dt * 64.0);
      ABAR[idx] = make_float2((float)ar, (float)ai); AT[idx] = make_float2((float)tr, (float)ti);
      const double nr = ar - 1.0, ni = ai, den = lr * lr + li * li;
      const double cr = (nr * lr + ni * li) / den, ci = (ni * lr - nr * li) / den;
      for (int cch = 0; cch < 16; ++cch) { const double br = (double)b_re[(size_t)idx * 16 + cch], bi = (double)b_im[(size_t)idx * 16 + cch];
        BBAR[(size_t)idx * 16 + cch] = make_float2((float)(cr * br - ci * bi), (float)(cr * bi + ci * br)); }
    }
  }
}

struct RowArgs { const bf16_t* Y; int g_post, m_gate; int do_norm, g_pre, m_shift, m_scale; int init, skip_ctx; const bf16_t* part; int ks; const bf16_t* glu_g; const float* glu_b; };
__device__ __forceinline__ void phase_row(const Params& p, const RowArgs a) {
  const int tid = threadIdx.x, lane = tid & 63, wid = tid >> 6;
  const float* NG = p.in[6]; const float* MOD = (const float*)(p.ws + WS_MOD);
  bf16_t* XB = (bf16_t*)(p.ws + WS_XB); bf16_t* H = (bf16_t*)p.out;
  const bool fin = !a.do_norm;
  const int gw = blockIdx.x * 8 + wid, nw = gridDim.x * 8;
  float4 xr0 = make_float4(0.f, 0.f, 0.f, 0.f), xr1 = xr0, xr2 = xr0, xr3 = xr0; uint2 xq0 = make_uint2(0u, 0u), xq1 = xq0, xq2 = xq0, xq3 = xq0;
  uint2 yr0 = make_uint2(0u, 0u), yr1 = yr0, yr2 = yr0, yr3 = yr0;
#define ROW_LOAD(R) do { \
    if (a.init) { const int b_ = (R) / TT, t_ = (R) - b_ * TT; \
      const float* xi_ = (t_ < CTXL) ? p.in[2] + ((size_t)b_ * CTXL + t_) * DM : p.in[0] + ((size_t)b_ * SEQ + (t_ - CTXL)) * DM; \
      xr0 = *(const float4*)(xi_ + lane * 4); xr1 = *(const float4*)(xi_ + 256 + lane * 4); xr2 = *(const float4*)(xi_ + 512 + lane * 4); xr3 = *(const float4*)(xi_ + 768 + lane * 4); } \
    else { const bf16_t* xi_ = XB + (size_t)(R) * DM + lane * 4; xq0 = *(const uint2*)(xi_); xq1 = *(const uint2*)(xi_ + 256); xq2 = *(const uint2*)(xi_ + 512); xq3 = *(const uint2*)(xi_ + 768); } \
    if (a.Y) { const bf16_t* yi_ = a.Y + (size_t)(R) * DM + lane * 4; yr0 = *(const uint2*)(yi_); yr1 = *(const uint2*)(yi_ + 256); yr2 = *(const uint2*)(yi_ + 512); yr3 = *(const uint2*)(yi_ + 768); } } while (0)
  if (gw < MR) ROW_LOAD(gw);
  for (int row = gw; row < MR; row += nw) {
    const int b = row / TT, t = row - b * TT;
    const bool isctx = t < CTXL;
    float x[16]; uint2 yc[4];
    if (a.init) { x[0] = xr0.x; x[1] = xr0.y; x[2] = xr0.z; x[3] = xr0.w; x[4] = xr1.x; x[5] = xr1.y; x[6] = xr1.z; x[7] = xr1.w;
      x[8] = xr2.x; x[9] = xr2.y; x[10] = xr2.z; x[11] = xr2.w; x[12] = xr3.x; x[13] = xr3.y; x[14] = xr3.z; x[15] = xr3.w; }
    else { const uint2 q4[4] = {xq0, xq1, xq2, xq3};
#pragma unroll
      for (int j = 0; j < 4; ++j) { const h16x4_t hv = __builtin_bit_cast(h16x4_t, q4[j]); x[4 * j] = (float)hv[0]; x[4 * j + 1] = (float)hv[1]; x[4 * j + 2] = (float)hv[2]; x[4 * j + 3] = (float)hv[3]; } }
    yc[0] = yr0; yc[1] = yr1; yc[2] = yr2; yc[3] = yr3;
    if (row + nw < MR) ROW_LOAD(row + nw);
    if (isctx && a.skip_ctx) continue;
    const int b9 = isctx ? 8 : b;
    if (a.Y) {
      float y[16]; float ss = 0.f;
#pragma unroll
      for (int j = 0; j < 4; ++j) {
        if (isctx && a.part) { y[4 * j] = 0.f; y[4 * j + 1] = 0.f; y[4 * j + 2] = 0.f; y[4 * j + 3] = 0.f;
          for (int ks = 0; ks < a.ks; ++ks) { const uint2 v = *(const uint2*)(a.part + ((size_t)b * CTXL + t) * (size_t)(a.ks * DM) + ks * DM + j * 256 + lane * 4);
            y[4 * j] += __uint_as_float(v.x << 16); y[4 * j + 1] += __uint_as_float(v.x & 0xffff0000u); y[4 * j + 2] += __uint_as_float(v.y << 16); y[4 * j + 3] += __uint_as_float(v.y & 0xffff0000u); }
          if (a.glu_g) {
            const uint2 gv = *(const uint2*)(a.glu_g + (size_t)row * DM + j * 256 + lane * 4); const float4 bv = *(const float4*)(a.glu_b + j * 256 + lane * 4);
            y[4 * j] = __uint_as_float(gv.x << 16) * frcp(1.0f + __expf(-(y[4 * j] + bv.x))); y[4 * j + 1] = __uint_as_float(gv.x & 0xffff0000u) * frcp(1.0f + __expf(-(y[4 * j + 1] + bv.y)));
            y[4 * j + 2] = __uint_as_float(gv.y << 16) * frcp(1.0f + __expf(-(y[4 * j + 2] + bv.z))); y[4 * j + 3] = __uint_as_float(gv.y & 0xffff0000u) * frcp(1.0f + __expf(-(y[4 * j + 3] + bv.w))); } }
        else { const uint2 v = yc[j];
          y[4 * j] = __uint_as_float(v.x << 16); y[4 * j + 1] = __uint_as_float(v.x & 0xffff0000u); y[4 * j + 2] = __uint_as_float(v.y << 16); y[4 * j + 3] = __uint_as_float(v.y & 0xffff0000u); } }
#pragma unroll
      for (int e = 0; e < 16; ++e) ss += y[e] * y[e];
      ss = wave_sum(ss); const float rs = rsqrtf(ss * (1.0f / DM) + EPS);
      const float* gp = NG + (size_t)a.g_post * DM; const float* gate = MOD + ((size_t)(a.m_gate / 6) * 9 + b9) * 6144 + (a.m_gate % 6) * DM;
#pragma unroll
      for (int j = 0; j < 4; ++j) { const float4 gv = *(const float4*)(gp + j * 256 + lane * 4); const float4 tv = *(const float4*)(gate + j * 256 + lane * 4);
        x[4 * j] += tv.x * (y[4 * j] * rs * gv.x); x[4 * j + 1] += tv.y * (y[4 * j + 1] * rs * gv.y); x[4 * j + 2] += tv.z * (y[4 * j + 2] * rs * gv.z); x[4 * j + 3] += tv.w * (y[4 * j + 3] * rs * gv.w); }
    }
    if (fin) {
      float* op = p.out + ((size_t)b * SEQ + (t - CTXL)) * DM;
#pragma unroll
      for (int j = 0; j < 4; ++j) *(float4*)(op + j * 256 + lane * 4) = make_float4(x[4 * j], x[4 * j + 1], x[4 * j + 2], x[4 * j + 3]);
    } else if (a.Y || a.init) {
#pragma unroll
      for (int j = 0; j < 4; ++j) { const h16x4_t hv = {(_Float16)x[4 * j], (_Float16)x[4 * j + 1], (_Float16)x[4 * j + 2], (_Float16)x[4 * j + 3]};
        *(uint2*)(XB + (size_t)row * DM + j * 256 + lane * 4) = __builtin_bit_cast(uint2, hv); }
    }
    if (a.do_norm) {
      float ss = 0.f;
#pragma unroll
      for (int e = 0; e < 16; ++e) ss += x[e] * x[e];
      ss = wave_sum(ss); const float rs = rsqrtf(ss * (1.0f / DM) + EPS);
      const float* gp = NG + (size_t)a.g_pre * DM;
      const float* sh = MOD + ((size_t)(a.m_shift / 6) * 9 + b9) * 6144 + (a.m_shift % 6) * DM;
      const float* scl = MOD + ((size_t)(a.m_scale / 6) * 9 + b9) * 6144 + (a.m_scale % 6) * DM;
#pragma unroll
      for (int j = 0; j < 4; ++j) { const float4 gv = *(const float4*)(gp + j * 256 + lane * 4); const float4 sv = *(const float4*)(sh + j * 256 + lane * 4); const float4 cv = *(const float4*)(scl + j * 256 + lane * 4);
        const float h0 = x[4 * j] * rs * gv.x * (1.0f + cv.x) + sv.x, h1 = x[4 * j + 1] * rs * gv.y * (1.0f + cv.y) + sv.y;
        const float h2 = x[4 * j + 2] * rs * gv.z * (1.0f + cv.z) + sv.z, h3 = x[4 * j + 3] * rs * gv.w * (1.0f + cv.w) + sv.w;
        uint2 o; o.x = pk2(h0, h1); o.y = pk2(h2, h3);
        *(uint2*)(H + (size_t)row * DM + j * 256 + lane * 4) = o; }
    }
  }
}

template <int ACT>
__device__ __forceinline__ void phase_gemm(unsigned char* lds, const bf16_t* A, const bf16_t* Bt, int N, int K, bf16_t* O, int ldc, const float* bias, const bf16_t* aux) {
  pg8::Gemm g{A, Bt, MR, N, K, K, K}; pg8::StaticOrder S; S.init(MR, N, (int)gridDim.x, (int)blockIdx.x, K, K);
  pg8::EpiB<ACT> E{O, ldc, bias, aux};
  pg8::gemm_phase<pg8::EpiB<ACT>, pg8::StaticOrder, false>((PG8_LAS unsigned char*)lds, g, S, E, nullptr);
  __syncthreads();
}
template <int ACT>
__device__ __forceinline__ void phase_gemm_lat(unsigned char* lds, const bf16_t* A, const bf16_t* Bt, int N, int K, bf16_t* O, int ldc, const float* bias = nullptr, const bf16_t* aux = nullptr) {
  pg8::Gemm g{A, Bt, MR, N, K, K, K}; pg8::LatOrder S; S.init(N, (int)gridDim.x, (int)blockIdx.x, K, K);
  pg8::EpiB<ACT> E{O, ldc, bias, aux};
  pg8::gemm_phase<pg8::EpiB<ACT>, pg8::LatOrder, false>((PG8_LAS unsigned char*)lds, g, S, E, nullptr);
  __syncthreads();
}
__device__ __forceinline__ void phase_gemm_ctxsplit(unsigned char* lds, const bf16_t* A, const bf16_t* Bt, int N, int K, int KS, bf16_t* PART) {
  pg8::Gemm g{A, Bt, MR, N, K / KS, K, K}; pg8::CtxSplitOrder S; S.init(N, KS, K / KS, (int)gridDim.x, (int)blockIdx.x, K, K);
  pg8::EpiB<0> E{PART, KS * N, nullptr, nullptr};
  pg8::gemm_phase<pg8::EpiB<0>, pg8::CtxSplitOrder, false>((PG8_LAS unsigned char*)lds, g, S, E, nullptr);
  __syncthreads();
}

__device__ __forceinline__ void phase_gqa_qknorm(const Params& p, bf16_t* QKV) {
  const int tid = threadIdx.x, lane = tid & 63, wid = tid >> 6;
  const float* qn = p.in[10]; const float* kn = p.in[11];
  const int gw = blockIdx.x * 8 + wid, nw = gridDim.x * 8;
  const int hf = lane >> 5, i = lane & 31, d1 = hf * 64 + i, d2 = d1 + 32;
  const float inv = exp2f(-(float)i * (13.287712379549449f / 32.0f));
  const float gq1 = qn[d1], gq2 = qn[d2], gk1 = kn[d1], gk2 = kn[d2];
  for (int row = gw; row < MR; row += nw) {
    const int t = row % TT;
    bf16_t* base = QKV + (size_t)row * 1536;
    bf16_t r1[10], r2[10];
#pragma unroll
    for (int hd = 0; hd < 10; ++hd) { const int off = hd < 8 ? hd * 128 : 1024 + (hd - 8) * 128; r1[hd] = base[off + d1]; r2[hd] = base[off + d2]; }
    float sn = 0.f, cs = 1.f;
    if (t >= CTXL) { const int tl = t - CTXL; const float pos = hf ? (float)(tl & 63) : (float)(tl >> 6); sincosf(pos * inv, &sn, &cs); }
#pragma unroll
    for (int hd = 0; hd < 10; ++hd) { const int off = hd < 8 ? hd * 128 : 1024 + (hd - 8) * 128;
      float x1 = bf2f(r1[hd]), x2 = bf2f(r2[hd]);
      const float ss = wave_sum(x1 * x1 + x2 * x2); const float rs = rsqrtf(ss * (1.0f / 128.0f) + EPS);
      x1 *= rs * (hd < 8 ? gq1 : gk1); x2 *= rs * (hd < 8 ? gq2 : gk2);
      const float o1 = x1 * cs - x2 * sn, o2 = x1 * sn + x2 * cs;
      base[off + d1] = f2bf(o1); base[off + d2] = f2bf(o2); }
  }
}

__device__ __forceinline__ void phase_gqa_attn(unsigned char* lds, const bf16_t* QKV, bf16_t* Ob) {
  for (int u = blockIdx.x; u < 576; u += gridDim.x) {
    const bf16_t *Q, *K; bf16_t* O; int seq;
    if (u < 512) { const int b = u >> 6, h = (u >> 3) & 7, qb = u & 7;
      Q = QKV + ((size_t)b * TT + CTXL + qb * 256) * 1536 + h * 128; K = QKV + (size_t)b * TT * 1536 + 1024 + (h >> 2) * 128;
      O = Ob + ((size_t)b * TT + CTXL + qb * 256) * DM + h * 128; seq = TT; }
    else { const int uu = u - 512, b = uu >> 3, h = uu & 7;
      Q = QKV + (size_t)b * TT * 1536 + h * 128; K = QKV + (size_t)b * TT * 1536 + 1024 + (h >> 2) * 128;
      O = Ob + (size_t)b * TT * DM + h * 128; seq = CTXL; }
    att::attn_dense_body<att::bf16>(Q, K, K + 256, O, seq, (char*)lds);
    __syncthreads();
  }
}

__device__ __forceinline__ int s5_seqidx(int k, int dir) { return dir == 0 ? k : (k < 4 ? 3 - k : 39 - k); }
__device__ __forceinline__ int s5_seq8(int cn, int dir) { return dir == 0 ? cn : (cn < 32 ? 31 - cn : 319 - cn); }
__device__ __forceinline__ float2 cmulf(float2 a, float2 b) { return make_float2(a.x * b.x - a.y * b.y, a.x * b.y + a.y * b.x); }

__device__ __forceinline__ void s5_build_tables(const Params& p, unsigned char* lds) {
  const int tid = threadIdx.x;
  const float2* ABAR = (const float2*)(p.ws + WS_S5A); const float2* BBAR = ABAR + 16384;
  const float* c_re = p.in[18]; const float* c_im = p.in[19];
  bf16_t* ET = (bf16_t*)(p.ws + WS_S5T); bf16_t* FT = ET + 128 * 16384; bf16_t* KFT = FT + 128 * 16384;
  float2* PW = (float2*)lds;
  float* Kt = (float*)(PW + 512);
  for (int job = blockIdx.x; job < 256; job += gridDim.x) {
    const int gd = job & 127, part = job >> 7, dir = gd >> 6;
    const int pp = tid >> 3, j = tid & 7;
    const float2 a = ABAR[gd * 64 + pp];
    if (part == 0) {
      { float2 w = make_float2(1.f, 0.f); for (int q = 0; q < j; ++q) w = cmulf(w, a); PW[pp * 8 + j] = w; }
      __syncthreads();
      { const float2 w = PW[pp * 8 + (dir == 0 ? 7 - j : j)];
        for (int c = 0; c < 16; ++c) { const float2 v = cmulf(w, BBAR[(size_t)(gd * 64 + pp) * 16 + c]);
          ET[(size_t)gd * 16384 + (2 * pp) * 128 + j * 16 + c] = f2bf(v.x); ET[(size_t)gd * 16384 + (2 * pp + 1) * 128 + j * 16 + c] = f2bf(v.y); } }
      for (int q = 0; q < 4; ++q) { const int idx = tid * 4 + q, tau = idx >> 8, c = (idx >> 4) & 15, c2 = idx & 15; float acc = 0.f;
        for (int p2 = 0; p2 < 64; ++p2) { const float2 cc = make_float2(c_re[((size_t)gd * 16 + c) * 64 + p2], c_im[((size_t)gd * 16 + c) * 64 + p2]);
          const float2 z = cmulf(cc, PW[p2 * 8 + tau]); const float2 bb = BBAR[(size_t)(gd * 64 + p2) * 16 + c2]; acc += z.x * bb.x - z.y * bb.y; }
        Kt[idx] = acc; }
      __syncthreads();
      for (int q = 0; q < 8; ++q) { const int idx = tid * 8 + q, dl = idx >> 9, c = (idx >> 5) & 15, k = idx & 31; float v;
        if (dir == 0) v = k < 16 ? Kt[(dl * 16 + c) * 16 + k] : (dl >= 1 ? Kt[((dl - 1) * 16 + c) * 16 + k - 16] : 0.f);
        else          v = k < 16 ? (dl >= 1 ? Kt[((dl - 1) * 16 + c) * 16 + k] : 0.f) : Kt[(dl * 16 + c) * 16 + k - 16];
        KFT[(size_t)gd * 4096 + idx] = f2bf(v); }
      __syncthreads();
    } else {
      const int e = dir == 0 ? j + 1 : 8 - j; float2 z0 = make_float2(1.f, 0.f); for (int q = 0; q < e; ++q) z0 = cmulf(z0, a);
      for (int c = 0; c < 16; ++c) { const float2 cc = make_float2(c_re[((size_t)gd * 16 + c) * 64 + pp], c_im[((size_t)gd * 16 + c) * 64 + pp]); const float2 z = cmulf(cc, z0);
        FT[(size_t)gd * 16384 + (j * 16 + c) * 128 + 2 * pp] = f2bf(z.x); FT[(size_t)gd * 16384 + (j * 16 + c) * 128 + 2 * pp + 1] = f2bf(-z.y); }
    }
  }
}

__device__ __forceinline__ void s5_load_tab(bf16_t* dst, const bf16_t* src, int tid) {
#pragma unroll
  for (int it = 0; it < 4; ++it) { const int idx = tid + it * 512, row = idx >> 4, ch = idx & 15; *(uint4*)(dst + row * 136 + ch * 8) = *(const uint4*)(src + row * 128 + ch * 8); }
}
__device__ __forceinline__ void s5_load_u(bf16x8_t (&uf)[4], const bf16_t* H, int b, int g, int ct, int fr, int fq) {
#pragma unroll
  for (int ks = 0; ks < 4; ++ks) uf[ks] = *(const bf16x8_t*)(H + ((size_t)b * TT + ct * 128 + fr * 8 + 2 * ks + (fq >> 1)) * DM + g * 16 + 8 * (fq & 1));
}

__device__ __forceinline__ void phase_s5_local(const Params& p, unsigned char* lds, bf16_t* SLOC) {
  const int tid = threadIdx.x, lane = tid & 63, wid = tid >> 6, fr = lane & 15, fq = lane >> 4;
  const bf16_t* H = (const bf16_t*)p.out;
  const bf16_t* ET = (const bf16_t*)(p.ws + WS_S5T);
  bf16_t* El = (bf16_t*)lds;
  for (int job = blockIdx.x; job < 256; job += gridDim.x) {
    const int gd = job & 127, half = job >> 7, dir = gd >> 6, g = gd & 63;
    __syncthreads();
    s5_load_tab(El, ET + (size_t)gd * 16384, tid);
    __syncthreads();
    for (int i = 0; i < 9; ++i) {
      const int cti = half * 72 + wid * 9 + i, b = cti / 18, ct = cti - b * 18;
      bf16x8_t uf[4]; s5_load_u(uf, H, b, g, ct, fr, fq);
      const int cn = ct * 16 + fr;
      bf16_t* dst = SLOC + ((size_t)((b * 64 + g) * 2 + dir) * 288 + s5_seq8(cn, dir)) * 128;
#pragma unroll
      for (int rt = 0; rt < 8; ++rt) { f32x4_t acc = (f32x4_t){0.f, 0.f, 0.f, 0.f};
#pragma unroll
        for (int ks = 0; ks < 4; ++ks) { const bf16x8_t af = *(const bf16x8_t*)(El + (16 * rt + fr) * 136 + 32 * ks + 8 * fq); acc = MFMA16(af, uf[ks], acc); }
        uint2 o; o.x = pk2(acc[0], acc[1]); o.y = pk2(acc[2], acc[3]);
        *(uint2*)(dst + 16 * rt + 4 * fq) = o; }
    }
  }
}

__device__ __forceinline__ void phase_s5_carry(const Params& p, const bf16_t* SLOC, bf16_t* SIN) {
  const float2* ABAR = (const float2*)(p.ws + WS_S5A);
  for (int idx = blockIdx.x * 512 + threadIdx.x; idx < NB * 64 * 2 * 64; idx += gridDim.x * 512) {
    const int pp = idx & 63, bgd = idx >> 6; const int dir = bgd & 1, g = (bgd >> 1) & 63;
    float2 a = ABAR[(dir * 64 + g) * 64 + pp]; a = cmulf(a, a); a = cmulf(a, a); a = cmulf(a, a);
    float sr = 0.f, si = 0.f;
    const unsigned* src = (const unsigned*)(SLOC + (size_t)bgd * 288 * 128) + pp; unsigned* dst = (unsigned*)(SIN + (size_t)bgd * 288 * 128) + pp;
    for (int kk0 = 0; kk0 < 288; kk0 += 32) {
      unsigned lv[32];
#pragma unroll
      for (int j = 0; j < 32; ++j) lv[j] = src[(kk0 + j) * 64];
#pragma unroll
      for (int j = 0; j < 32; ++j) { const unsigned l = lv[j];
        dst[(kk0 + j) * 64] = pk2(sr, si);
        const float lr = __uint_as_float(l << 16), li = __uint_as_float(l & 0xffff0000u);
        const float nr = a.x * sr - a.y * si + lr, ni = a.x * si + a.y * sr + li; sr = nr; si = ni; } }
  }
}

__device__ __forceinline__ void phase_s5_full(const Params& p, unsigned char* lds, const bf16_t* SIN, bf16_t* G) {
  const int tid = threadIdx.x, lane = tid & 63, wid = tid >> 6, fr = lane & 15, fq = lane >> 4;
  const bf16_t* H = (const bf16_t*)p.out;
  const bf16_t* FT = (const bf16_t*)(p.ws + WS_S5T) + 128 * 16384; const bf16_t* KFT = FT + 128 * 16384;
  const float* dsk = p.in[20];
  bf16_t* Fl = (bf16_t*)lds;
  bf16_t* Kl = Fl + 2 * 128 * 136;
  for (int job = blockIdx.x; job < 256; job += gridDim.x) {
    const int g = job & 63, quarter = job >> 6;
    __syncthreads();
    s5_load_tab(Fl, FT + (size_t)g * 16384, tid); s5_load_tab(Fl + 128 * 136, FT + (size_t)(64 + g) * 16384, tid);
    { const int d = tid >> 8, idx = tid & 255; *(uint4*)(Kl + d * 4096 + idx * 8) = *(const uint4*)(KFT + (size_t)(d * 64 + g) * 4096 + idx * 8);
      *(uint4*)(Kl + d * 4096 + 2048 + idx * 8) = *(const uint4*)(KFT + (size_t)(d * 64 + g) * 4096 + 2048 + idx * 8); }
    __syncthreads();
    for (int i = wid; i < 36; i += 8) {
      const int cti = quarter * 36 + i, b = cti / 18, ct = cti - b * 18;
      bf16x8_t uf[4]; s5_load_u(uf, H, b, g, ct, fr, fq);
      const int cn = ct * 16 + fr;
      f32x4_t acc[8];
#pragma unroll
      for (int t = 0; t < 8; ++t) acc[t] = (f32x4_t){0.f, 0.f, 0.f, 0.f};
      bf16x8_t sfa[2][4]; uint2 hv8[8];
#pragma unroll
      for (int dir = 0; dir < 2; ++dir) { const bf16_t* sp = SIN + ((size_t)((b * 64 + g) * 2 + dir) * 288 + s5_seq8(cn, dir)) * 128;
#pragma unroll
        for (int ks = 0; ks < 4; ++ks) sfa[dir][ks] = *(const bf16x8_t*)(sp + 32 * ks + 8 * fq); }
#pragma unroll
      for (int t = 0; t < 8; ++t) hv8[t] = *(const uint2*)(H + ((size_t)b * TT + ct * 128 + fr * 8 + t) * DM + g * 16 + 4 * fq);
#pragma unroll
      for (int dir = 0; dir < 2; ++dir) {
        bf16x8_t sf[4];
#pragma unroll
        for (int ks = 0; ks < 4; ++ks) sf[ks] = sfa[dir][ks];
        const bf16_t* Kd = Kl + dir * 4096; const bf16_t* Fd = Fl + dir * 128 * 136;
#pragma unroll
        for (int t = 0; t < 8; ++t) {
#pragma unroll
          for (int ks = 0; ks < 4; ++ks) { const int dl = dir == 0 ? t - 2 * ks : 2 * ks + 1 - t;
            if (dl >= 0) { const bf16x8_t af = *(const bf16x8_t*)(Kd + (dl * 16 + fr) * 32 + 8 * fq); acc[t] = MFMA16(af, uf[ks], acc[t]); } }
#pragma unroll
          for (int ks = 0; ks < 4; ++ks) { const bf16x8_t af = *(const bf16x8_t*)(Fd + (t * 16 + fr) * 136 + 32 * ks + 8 * fq); acc[t] = MFMA16(af, sf[ks], acc[t]); }
          __builtin_amdgcn_sched_barrier(0);
        }
      }
      const float4 dv = *(const float4*)(dsk + g * 16 + 4 * fq);
#pragma unroll
      for (int t = 0; t < 8; ++t) { const size_t off = ((size_t)b * TT + ct * 128 + fr * 8 + t) * DM + g * 16 + 4 * fq;
        const uint2 hv = hv8[t];
        const float h0 = __uint_as_float(hv.x << 16), h1 = __uint_as_float(hv.x & 0xffff0000u), h2 = __uint_as_float(hv.y << 16), h3 = __uint_as_float(hv.y & 0xffff0000u);
        float z[4] = {h0 * dv.x + acc[t][0], h1 * dv.y + acc[t][1], h2 * dv.z + acc[t][2], h3 * dv.w + acc[t][3]};
#pragma unroll
        for (int q = 0; q < 4; ++q) { const float zz = z[q]; const float t3 = 0.7978845608028654f * (zz + 0.044715f * zz * zz * zz); z[q] = zz * frcp(1.0f + __expf(-2.0f * t3)); }
        uint2 o; o.x = pk2(z[0], z[1]); o.y = pk2(z[2], z[3]);
        *(uint2*)(G + off) = o;
        if (t & 1) __builtin_amdgcn_sched_barrier(0); }
    }
  }
}

__device__ __forceinline__ void phase_ssd_conv(const Params& p, const bf16_t* P1, bf16_t* XBC) {
  const float* cw = p.in[24]; const float* cb = p.in[25]; const float* dtb = p.in[26];
  float* DT = (float*)(p.ws + WS_DT);
  const size_t gt = (size_t)blockIdx.x * 512 + threadIdx.x, nthr = (size_t)gridDim.x * 512;
  {
    for (size_t item = gt; item < (size_t)(MR / 16) * 384; item += nthr) {
      const int cg8 = (int)(item % 384) * 8, run = (int)(item / 384); const int row0 = run * 16, t0 = row0 % TT;
      const int lo = t0 < CTXL ? 0 : CTXL, hi = t0 < CTXL ? CTXL : TT;
      float w[5][8], bs[8];
      { const float4 b0 = *(const float4*)(cb + cg8), b1 = *(const float4*)(cb + cg8 + 4); bs[0] = b0.x; bs[1] = b0.y; bs[2] = b0.z; bs[3] = b0.w; bs[4] = b1.x; bs[5] = b1.y; bs[6] = b1.z; bs[7] = b1.w; }
#pragma unroll
      for (int k = 0; k < 5; ++k) { const float4 w0 = *(const float4*)(cw + k * 3072 + cg8), w1 = *(const float4*)(cw + k * 3072 + cg8 + 4);
        w[k][0] = w0.x; w[k][1] = w0.y; w[k][2] = w0.z; w[k][3] = w0.w; w[k][4] = w1.x; w[k][5] = w1.y; w[k][6] = w1.z; w[k][7] = w1.w; }
      uint4 xr[20];
      { const int segrow0 = row0 - t0 + lo, segrow1 = row0 - t0 + hi - 1;
#pragma unroll
        for (int k = 0; k < 20; ++k) { const int rr = min(max(row0 + k - 2, segrow0), segrow1); xr[k] = *(const uint4*)(P1 + (size_t)rr * SSD_N1 + cg8); }
#pragma unroll
        for (int k = 0; k < 20; ++k) { const int tt = t0 + k - 2; if (!(tt >= lo && tt < hi)) xr[k] = make_uint4(0u, 0u, 0u, 0u); } }
      float x[5][8];
#pragma unroll
      for (int k = 0; k < 4; ++k) unpack8(xr[k], x[k + 1]);
#pragma unroll
      for (int r = 0; r < 16; ++r) {
#pragma unroll
        for (int k = 0; k < 4; ++k)
#pragma unroll
          for (int q = 0; q < 8; ++q) x[k][q] = x[k + 1][q];
        unpack8(xr[r + 4], x[4]);
        float acc[8];
#pragma unroll
        for (int q = 0; q < 8; ++q) { float sacc = bs[q];
#pragma unroll
          for (int k = 0; k < 5; ++k) sacc += w[k][q] * x[k][q];
          acc[q] = silu_f(sacc); }
        *(uint4*)(XBC + (size_t)(row0 + r) * 3072 + cg8) = pack8(acc);
      }
    }
  }
  for (size_t idx = gt; idx < (size_t)MR * 64; idx += 3 * nthr) {
    float v3[3];
#pragma unroll
    for (int u = 0; u < 3; ++u) { const size_t i2 = idx + u * nthr; v3[u] = i2 < (size_t)MR * 64 ? bf2f(P1[(size_t)(i2 >> 6) * SSD_N1 + 3072 + (int)(i2 & 63)]) + dtb[i2 & 63] : 0.f; }
#pragma unroll
    for (int u = 0; u < 3; ++u) { const size_t i2 = idx + u * nthr; if (i2 < (size_t)MR * 64) DT[i2] = v3[u] > 20.f ? v3[u] : log1pf(expf(v3[u])); }
  }
}

__device__ __forceinline__ void tr_frag2(bf16x8_t& f0, bf16x8_t& f1, const void* base0, const void* base1, int rs, int k0, int n0, int k1, int n1, int lane) {
  const int g = lane >> 4, qq = (lane & 15) >> 2, pp = lane & 3;
  const unsigned a0 = (unsigned)(uintptr_t)base0 + (unsigned)((k0 + 8 * g + qq) * rs + (n0 + 4 * pp) * 2), a1 = a0 + 4u * (unsigned)rs;
  const unsigned b0 = (unsigned)(uintptr_t)base1 + (unsigned)((k1 + 8 * g + qq) * rs + (n1 + 4 * pp) * 2), b1 = b0 + 4u * (unsigned)rs;
  s16x4_t l0, h0, l1, h1;
  asm volatile("ds_read_b64_tr_b16 %0, %4\n\tds_read_b64_tr_b16 %1, %5\n\tds_read_b64_tr_b16 %2, %6\n\tds_read_b64_tr_b16 %3, %7\n\ts_waitcnt lgkmcnt(0)"
               : "=&v"(l0), "=&v"(h0), "=&v"(l1), "=&v"(h1) : "v"(a0), "v"(a1), "v"(b0), "v"(b1) : "memory");
  f0 = (bf16x8_t){l0[0], l0[1], l0[2], l0[3], h0[0], h0[1], h0[2], h0[3]};
  f1 = (bf16x8_t){l1[0], l1[1], l1[2], l1[3], h1[0], h1[1], h1[2], h1[3]};
}
__device__ __forceinline__ void phase_ssd_scan(const Params& p, unsigned char* lds, const bf16_t* XBC, bf16_t* YS) {
  const int tid0 = threadIdx.x, wid = tid0 >> 6;
  const float* DT = (const float*)(p.ws + WS_DT); const float* a_log = p.in[27]; const float* dskip = p.in[28];
  bf16_t* Cs = (bf16_t*)lds;
  bf16_t* Bs = Cs + 64 * 136;
  bf16_t* St = Bs + 64 * 136;
  bf16_t* Xd = St + 128 * 72;
  bf16_t* Xw = Xd + 64 * 72;
  bf16_t* Xr = Xw + 64 * 72;
  bf16_t* Ps = Xr + 64 * 72;
  float* cum = (float*)(Ps + 64 * 72);
  float* dts = cum + 64;
  float* tot = dts + 64;
  for (int item = blockIdx.x; item < NB * 32; item += gridDim.x) {
    const int b = item >> 5, h = item & 31, gr = h >> 3;
    const float dsk = dskip[h];
    for (int dir = 0; dir < 2; ++dir) {
      const float a = -expf(a_log[dir * 32 + h]);
      f32x4_t S[4];
#pragma unroll
      for (int q = 0; q < 4; ++q) S[q] = (f32x4_t){0.f, 0.f, 0.f, 0.f};
      LDS_BAR();
      for (int i = tid0; i < 128 * 72 / 2; i += 512) ((unsigned*)St)[i] = 0u;
      uint4 pvb0, pvb1, pvc0, pvc1, pvx; float pdt = 0.f;
      int tid = tid0, lane = tid0 & 63, fr = lane & 15, fq = lane >> 4;
#define SSD_ISSUE(KK) do { const int k_ = s5_seqidx((KK), dir); const size_t r_ = (size_t)b * TT + k_ * 64; \
        { const int l = tid >> 4, c8 = (tid & 15) * 8; \
          pvb0 = *(const uint4*)(XBC + (r_ + l) * 3072 + 2048 + gr * 128 + c8); pvc0 = *(const uint4*)(XBC + (r_ + l) * 3072 + 2560 + gr * 128 + c8); \
          pvb1 = *(const uint4*)(XBC + (r_ + l + 32) * 3072 + 2048 + gr * 128 + c8); pvc1 = *(const uint4*)(XBC + (r_ + l + 32) * 3072 + 2560 + gr * 128 + c8); } \
        { const int l = tid >> 3, c8 = (tid & 7) * 8; pvx = *(const uint4*)(XBC + (r_ + l) * 3072 + h * 64 + c8); } \
        if (wid == 0) pdt = DT[(r_ + lane) * 64 + dir * 32 + h]; } while (0)
      SSD_ISSUE(0);
      for (int kk = 0; kk < 36; ++kk) {
        const int k = s5_seqidx(kk, dir);
        const size_t row0 = (size_t)b * TT + k * 64;
        tid = tid0; asm volatile("" : "+v"(tid)); lane = tid & 63; fr = lane & 15; fq = lane >> 4;
        const int lt = wid >> 1, l_own = 16 * lt + fr;
        LDS_BAR();
        if (wid == 0) {
          const float dtv = pdt; float c = dtv * a;
          if (dir == 0) {
#pragma unroll
            for (int o = 1; o < 64; o <<= 1) { const float t = __shfl_up(c, o); if (lane >= o) c += t; } }
          else {
#pragma unroll
            for (int o = 1; o < 64; o <<= 1) { const float t = __shfl_down(c, o); if (lane + o < 64) c += t; } }
          cum[lane] = c; dts[lane] = dtv;
          if (dir == 0 ? lane == 63 : lane == 0) tot[0] = c;
        }
        { const int l = tid >> 4, c8 = (tid & 15) * 8;
          *(uint4*)(Bs + l * 136 + c8) = pvb0; *(uint4*)(Cs + l * 136 + c8) = pvc0;
          *(uint4*)(Bs + (l + 32) * 136 + c8) = pvb1; *(uint4*)(Cs + (l + 32) * 136 + c8) = pvc1; }
        const uint4 vx = pvx;
        uint2 yold[2];
#pragma unroll
        for (int p2 = 0; p2 < 2; ++p2) yold[p2] = make_uint2(0u, 0u);
        if (dir == 1) {
#pragma unroll
          for (int p2 = 0; p2 < 2; ++p2) yold[p2] = *(const uint2*)(YS + (row0 + l_own) * 2048 + h * 64 + 16 * ((wid & 1) * 2 + p2) + 4 * fq);
        }
        LDS_BAR();
        { const int l = tid >> 3, c8 = (tid & 7) * 8;
          const float dtl = dts[l], wl = __expf(tot[0] - cum[l]); float f[8], fw[8]; unpack8(vx, f);
#pragma unroll
          for (int q = 0; q < 8; ++q) { f[q] *= dtl; fw[q] = f[q] * wl; }
          *(uint4*)(Xr + l * 72 + c8) = vx; *(uint4*)(Xd + l * 72 + c8) = pack8(f); *(uint4*)(Xw + l * 72 + c8) = pack8(fw); }
        if (kk + 1 < 36) SSD_ISSUE(kk + 1);
        LDS_BAR();
        const float cl = cum[l_own];
        {
#pragma unroll
          for (int s2 = 0; s2 < 2; ++s2) { const int st = (wid & 1) * 2 + s2; f32x4_t g = (f32x4_t){0.f, 0.f, 0.f, 0.f};
#pragma unroll
            for (int ks = 0; ks < 4; ++ks) { const bf16x8_t af = *(const bf16x8_t*)(Bs + (16 * st + fr) * 136 + 32 * ks + 8 * fq);
              const bf16x8_t bfr = *(const bf16x8_t*)(Cs + l_own * 136 + 32 * ks + 8 * fq); g = MFMA16(af, bfr, g); }
            const float4 cs4 = *(const float4*)(cum + 16 * st + 4 * fq); const float csv[4] = {cs4.x, cs4.y, cs4.z, cs4.w}; float v[4];
#pragma unroll
            for (int r = 0; r < 4; ++r) { const int sidx = 16 * st + 4 * fq + r; const bool ok = dir == 0 ? sidx <= l_own : sidx >= l_own;
              v[r] = ok ? g[r] * __expf(cl - csv[r]) : 0.f; }
            uint2 o; o.x = pk2(v[0], v[1]); o.y = pk2(v[2], v[3]);
            *(uint2*)(Ps + l_own * 72 + 16 * st + 4 * fq) = o; } }
        LDS_BAR();
        { const float el = __expf(cl);
#pragma unroll
          for (int p2 = 0; p2 < 2; ++p2) { const int pt = (wid & 1) * 2 + p2; f32x4_t y1 = (f32x4_t){0.f, 0.f, 0.f, 0.f}, y2 = y1;
            { bf16x8_t a0, a1; tr_frag2(a0, a1, Xd, Xd, 144, 0, 16 * pt, 32, 16 * pt, lane);
              y1 = MFMA16(a0, *(const bf16x8_t*)(Ps + l_own * 72 + 8 * fq), y1); y1 = MFMA16(a1, *(const bf16x8_t*)(Ps + l_own * 72 + 32 + 8 * fq), y1); }
#pragma unroll
            for (int kp = 0; kp < 2; ++kp) { bf16x8_t a0, a1; tr_frag2(a0, a1, St, St, 144, 64 * kp, 16 * pt, 64 * kp + 32, 16 * pt, lane);
              y2 = MFMA16(a0, *(const bf16x8_t*)(Cs + l_own * 136 + 64 * kp + 8 * fq), y2); y2 = MFMA16(a1, *(const bf16x8_t*)(Cs + l_own * 136 + 64 * kp + 32 + 8 * fq), y2); }
            float y[4]; uint2 ad;
            if (dir == 0) { ad = *(const uint2*)(Xr + l_own * 72 + 16 * pt + 4 * fq); } else { ad = yold[p2]; }
            const float ads = dir == 0 ? dsk : 1.0f;
            y[0] = y1[0] + el * y2[0] + ads * __uint_as_float(ad.x << 16); y[1] = y1[1] + el * y2[1] + ads * __uint_as_float(ad.x & 0xffff0000u);
            y[2] = y1[2] + el * y2[2] + ads * __uint_as_float(ad.y << 16); y[3] = y1[3] + el * y2[3] + ads * __uint_as_float(ad.y & 0xffff0000u);
            uint2 o; o.x = pk2(y[0], y[1]); o.y = pk2(y[2], y[3]);
            *(uint2*)(YS + (row0 + l_own) * 2048 + h * 64 + 16 * pt + 4 * fq) = o; } }
        LDS_BAR();
        { const float et = __expf(tot[0]); bf16x8_t b0, b1; tr_frag2(b0, b1, Bs, Bs, 272, 0, 16 * wid, 32, 16 * wid, lane);
#pragma unroll
          for (int pt = 0; pt < 4; ++pt) { f32x4_t acc = S[pt] * et; bf16x8_t a0, a1; tr_frag2(a0, a1, Xw, Xw, 144, 0, 16 * pt, 32, 16 * pt, lane);
            acc = MFMA16(a0, b0, acc); acc = MFMA16(a1, b1, acc); S[pt] = acc;
            uint2 o; o.x = pk2(acc[0], acc[1]); o.y = pk2(acc[2], acc[3]);
            *(uint2*)(St + (16 * wid + fr) * 72 + 16 * pt + 4 * fq) = o; } }
      }
    }
  }
  LDS_BAR();
}

__device__ __forceinline__ void phase_ssd_gate(const Params& p, bf16_t* YS, const bf16_t* GATE, const bf16_t* PART) {
  const int tid = threadIdx.x, lane = tid & 63, wid = tid >> 6; const float* ng = p.in[29];
  const int gw = blockIdx.x * 8 + wid, nw = gridDim.x * 8;
  for (int item0 = gw * 2; item0 < MR * 4; item0 += nw * 2) {
    size_t off[2]; uint4 yv[2], gv[2];
#pragma unroll
    for (int u = 0; u < 2; ++u) { const int item = item0 + u; off[u] = (size_t)(item >> 2) * 2048 + (item & 3) * 512 + lane * 8; yv[u] = *(const uint4*)(YS + off[u]); gv[u] = *(const uint4*)(GATE + off[u]); }
#pragma unroll
    for (int u = 0; u < 2; ++u) { const int item = item0 + u;
      float y[8], g[8]; unpack8(yv[u], y); unpack8(gv[u], g);
      { const int row = item >> 2, bb = row / TT, t = row - bb * TT;
        if (t < CTXL) {
#pragma unroll
          for (int q = 0; q < 8; ++q) g[q] = 0.f;
          for (int ks = 0; ks < 4; ++ks) { float pg[8]; unpack8(*(const uint4*)(PART + ((size_t)bb * CTXL + t) * 8192 + ks * 2048 + (item & 3) * 512 + lane * 8), pg);
#pragma unroll
            for (int q = 0; q < 8; ++q) g[q] += pg[q]; } } }
      float ss = 0.f;
#pragma unroll
      for (int q = 0; q < 8; ++q) { y[q] *= silu_f(g[q]); ss += y[q] * y[q]; }
      ss = wave_sum(ss); const float rs = rsqrtf(ss * (1.0f / 512.0f) + EPS);
      const float* gp = ng + (item & 3) * 512 + lane * 8;
#pragma unroll
      for (int q = 0; q < 8; ++q) y[q] *= rs * gp[q];
      *(uint4*)(YS + off[u]) = pack8(y); }
  }
}

__device__ __forceinline__ void tr_frag4(bf16x8_t (&f)[4], const void* base, int rs, int lane) {
  const int g = lane >> 4, qq = (lane & 15) >> 2, pp = lane & 3;
  const unsigned a0 = (unsigned)(uintptr_t)base + (unsigned)((8 * g + qq) * rs + (4 * pp) * 2), a1 = a0 + 4u * (unsigned)rs;
  s16x4_t l0, h0, l1, h1, l2, h2, l3, h3;
  asm volatile("ds_read_b64_tr_b16 %0, %8\n\tds_read_b64_tr_b16 %1, %9\n\tds_read_b64_tr_b16 %2, %8 offset:32\n\tds_read_b64_tr_b16 %3, %9 offset:32\n\t"
               "ds_read_b64_tr_b16 %4, %8 offset:64\n\tds_read_b64_tr_b16 %5, %9 offset:64\n\tds_read_b64_tr_b16 %6, %8 offset:96\n\tds_read_b64_tr_b16 %7, %9 offset:96\n\ts_waitcnt lgkmcnt(0)"
               : "=&v"(l0), "=&v"(h0), "=&v"(l1), "=&v"(h1), "=&v"(l2), "=&v"(h2), "=&v"(l3), "=&v"(h3) : "v"(a0), "v"(a1) : "memory");
  f[0] = (bf16x8_t){l0[0], l0[1], l0[2], l0[3], h0[0], h0[1], h0[2], h0[3]}; f[1] = (bf16x8_t){l1[0], l1[1], l1[2], l1[3], h1[0], h1[1], h1[2], h1[3]};
  f[2] = (bf16x8_t){l2[0], l2[1], l2[2], l2[3], h2[0], h2[1], h2[2], h2[3]}; f[3] = (bf16x8_t){l3[0], l3[1], l3[2], l3[3], h3[0], h3[1], h3[2], h3[3]};
}
__device__ __forceinline__ void phase_na_attn(const Params& p, unsigned char* lds, const bf16_t* QKV, bf16_t* Ob) {
  const int tid0 = threadIdx.x, wid = tid0 >> 6;
  const float* rpb = p.in[32];
  bf16_t* Vl = (bf16_t*)lds;
  bf16_t* Vc = Vl + 512 * 72;
  unsigned char* Kc = (unsigned char*)(Vc + 256 * 72);
  float* mbuf = (float*)(Kc + 32768);
  float* lbuf = mbuf + 128;
  float* obuf = lbuf + 128;
  float* rl = obuf + 4096;
  const int wq = wid & 3; const bool isctx = wid >= 4;
  const int c0 = 16 * wq, cbase = min(max(c0 - 8, 0), 32);
  for (int job = blockIdx.x; job < NB * 16 * 2; job += gridDim.x) {
    const int b = job >> 5, hh = (job >> 1) & 15, rbase = (job & 1) * 16;
    const size_t brow = (size_t)b * TT;
    LDS_BAR();
#pragma unroll
    for (int it = 0; it < 4; ++it) { const int idx = tid0 + it * 512, key = idx >> 3, ch = idx & 7;
      *(uint4*)(Vc + key * 72 + ch * 8) = *(const uint4*)(QKV + (brow + key) * 3072 + 2048 + hh * 64 + ch * 8);
      *(uint4*)(Kc + key * 128 + ((ch ^ (key & 7)) << 4)) = *(const uint4*)(QKV + (brow + key) * 3072 + 1024 + hh * 64 + ch * 8); }
    if (tid0 < 465) rl[tid0] = rpb[hh * 465 + tid0];
    int have_hi = -1;
    for (int ri = 0; ri < 16; ++ri) {
      int tid = tid0; asm volatile("" : "+v"(tid));
      const int lane = tid & 63, fr = lane & 15, fq = lane >> 4;
      const int qcol = c0 + fr, cs = min(max(qcol - 8, 0), 48);
      const int kap = 8 * (fr >> 2) + (fr & 3);
      const int r = rbase + ri;
      const int r0 = min(max(r - 4, 0), 24);
      for (int gr = max(r0, have_hi + 1); gr <= r0 + 7; ++gr) { const int col = tid >> 3, ch = tid & 7;
        *(uint4*)(Vl + ((gr & 7) * 64 + col) * 72 + ch * 8) = *(const uint4*)(QKV + (brow + CTXL + gr * 64 + col) * 3072 + 2048 + hh * 64 + ch * 8); }
      have_hi = r0 + 7;
      const size_t qrow = brow + CTXL + r * 64 + qcol;
      bf16x8_t qf[2];
#pragma unroll
      for (int ks = 0; ks < 2; ++ks) qf[ks] = *(const bf16x8_t*)(QKV + qrow * 3072 + hh * 64 + 32 * ks + 8 * fq);
      if (ri == 0) LDS_BAR();
      f32x4_t s[16];
      float mx = -INFINITY;
      if (isctx) {
#pragma unroll
        for (int tile = 0; tile < 16; ++tile) { const int key = 32 * (tile >> 1) + kap + 4 * (tile & 1);
          f32x4_t acc = (f32x4_t){0.f, 0.f, 0.f, 0.f};
#pragma unroll
          for (int ks = 0; ks < 2; ++ks) { const bf16x8_t kf = *(const bf16x8_t*)(Kc + key * 128 + (((4 * ks + fq) ^ (key & 7)) << 4)); acc = MFMA16(kf, qf[ks], acc); }
          acc = acc * 0.125f; mx = fmaxf(mx, fmaxf(fmaxf(acc[0], acc[1]), fmaxf(acc[2], acc[3]))); s[tile] = acc; }
      } else {
#pragma unroll
        for (int tg = 0; tg < 2; ++tg) {
          bf16x8_t kf[8][2];
#pragma unroll
          for (int t4 = 0; t4 < 8; ++t4) { const int tile = tg * 8 + t4; const size_t krow = brow + CTXL + (r0 + (tile >> 1)) * 64 + cbase + kap + 4 * (tile & 1);
            kf[t4][0] = *(const bf16x8_t*)(QKV + krow * 3072 + 1024 + hh * 64 + 8 * fq); kf[t4][1] = *(const bf16x8_t*)(QKV + krow * 3072 + 1024 + hh * 64 + 32 + 8 * fq); }
#pragma unroll
          for (int t4 = 0; t4 < 8; ++t4) { f32x4_t acc = (f32x4_t){0.f, 0.f, 0.f, 0.f}; acc = MFMA16(kf[t4][0], qf[0], acc); acc = MFMA16(kf[t4][1], qf[1], acc); s[tg * 8 + t4] = acc; }
        }
#pragma unroll
        for (int tile = 0; tile < 16; ++tile) { const int i = tile >> 1, jh = tile & 1; const int rr = r0 + i - r + 7; f32x4_t acc = s[tile];
#pragma unroll
          for (int rg = 0; rg < 4; ++rg) { const int kcol = cbase + 8 * fq + 4 * jh + rg; const bool ok = kcol >= cs && kcol < cs + 16;
            const int crl = min(max(kcol - qcol + 15, 0), 30);
            const float v = ok ? acc[rg] * 0.125f + rl[rr * 31 + crl] : -INFINITY; acc[rg] = v; mx = fmaxf(mx, v); }
          s[tile] = acc; }
      }
      mx = fmaxf(mx, __shfl_xor(mx, 16)); mx = fmaxf(mx, __shfl_xor(mx, 32));
      if (fq == 0) mbuf[wid * 16 + fr] = mx;
      LDS_BAR();
      const float Mx = fmaxf(mbuf[wq * 16 + fr], mbuf[(wq + 4) * 16 + fr]);
      float ls = 0.f;
#pragma unroll
      for (int tile = 0; tile < 16; ++tile)
#pragma unroll
        for (int rg = 0; rg < 4; ++rg) { const float e = __expf(s[tile][rg] - Mx); s[tile][rg] = e; ls += e; }
      ls += __shfl_xor(ls, 16); ls += __shfl_xor(ls, 32);
      if (fq == 0) lbuf[wid * 16 + fr] = ls;
      f32x4_t o[4];
#pragma unroll
      for (int dt = 0; dt < 4; ++dt) o[dt] = (f32x4_t){0.f, 0.f, 0.f, 0.f};
#pragma unroll
      for (int ks8 = 0; ks8 < 8; ++ks8) {
        const f32x4_t pa = s[2 * ks8], pb = s[2 * ks8 + 1];
        const u32x4_t pw = (u32x4_t){pk2(pa[0], pa[1]), pk2(pa[2], pa[3]), pk2(pb[0], pb[1]), pk2(pb[2], pb[3])};
        const bf16x8_t pf = __builtin_bit_cast(bf16x8_t, pw);
        const bf16_t* vbase = isctx ? Vc + (32 * ks8) * 72 : Vl + ((((r0 + ks8) & 7) * 64) + cbase) * 72;
        bf16x8_t vf[4]; tr_frag4(vf, vbase, 144, lane);
#pragma unroll
        for (int dt = 0; dt < 4; ++dt) o[dt] = MFMA16(pf, vf[dt], o[dt]);
      }
      if (isctx) {
#pragma unroll
        for (int dt = 0; dt < 4; ++dt)
#pragma unroll
          for (int rg = 0; rg < 4; ++rg) obuf[(wq * 16 + 4 * fq + rg) * 64 + 16 * dt + fr] = o[dt][rg];
      }
      LDS_BAR();
      if (!isctx) {
#pragma unroll
        for (int rg = 0; rg < 4; ++rg) { const int qi = 4 * fq + rg; const float lt = lbuf[wq * 16 + qi] + lbuf[(wq + 4) * 16 + qi]; const float il = frcp(lt);
          bf16_t* op = Ob + (brow + CTXL + r * 64 + c0 + qi) * DM + hh * 64;
#pragma unroll
          for (int dt = 0; dt < 4; ++dt) op[16 * dt + fr] = f2bf((o[dt][rg] + obuf[(wq * 16 + qi) * 64 + 16 * dt + fr]) * il); }
      }
    }
  }
  LDS_BAR();
}

constexpr int NPHASE = 35;
__global__ void __launch_bounds__(512, 2) mega_fwd(Params p) {
  extern __shared__ __attribute__((aligned(16))) unsigned char lds[];
  cg::grid_group grid = cg::this_grid();
  unsigned char* ws = p.ws;
  bf16_t* H = (bf16_t*)p.out;
  unsigned char* BIG = ws + WS_BIG;
  int ph = 0;
#ifndef MK_DUPMASK
#define MK_DUPMASK 0ull
#endif
  unsigned* bar = (unsigned*)(ws + WS_BAR); unsigned nbar = 0;
  const unsigned xcc = (unsigned)__builtin_amdgcn_s_getreg((3 << 11) | 20) & 0xFu;
  volatile unsigned* bst = (volatile unsigned*)(lds + 163824);
  if (threadIdx.x == 0) { bst[0] = 0u; bst[1] = 0u; __hip_atomic_fetch_add(bar + 256 + 64 * xcc, 1u, __ATOMIC_RELAXED, __HIP_MEMORY_SCOPE_AGENT); }
#define XB_LD(pw) __hip_atomic_load((pw), __ATOMIC_RELAXED, __HIP_MEMORY_SCOPE_AGENT)
#define XB_ADD(pw) __hip_atomic_fetch_add((pw), 1u, __ATOMIC_RELAXED, __HIP_MEMORY_SCOPE_AGENT)
#define GSYNC() do { if (nbar == 0) { grid.sync(); } else { \
      asm volatile("s_waitcnt vmcnt(0)" ::: "memory"); \
      __syncthreads(); \
      if (threadIdx.x == 0) { \
        unsigned nloc = bst[0], nx = bst[1]; \
        if (nloc == 0u) { for (;;) { unsigned sum = 0u, cnt = 0u, mine = 0u; \
            for (unsigned j = 0; j < 16; ++j) { const unsigned c_ = XB_LD(bar + 256 + 64 * j); sum += c_; cnt += (c_ > 0u) ? 1u : 0u; mine = (j == xcc) ? c_ : mine; } \
            if (sum == gridDim.x) { nloc = mine; nx = cnt; break; } __builtin_amdgcn_s_sleep(2); } \
          bst[0] = nloc; bst[1] = nx; } \
        const unsigned old_ = XB_ADD(bar + 1280 + 64 * xcc); const unsigned gen_ = old_ / nloc; \
        if (old_ + 1u == (gen_ + 1u) * nloc) { \
          __builtin_amdgcn_fence(__ATOMIC_RELEASE, "agent"); asm volatile("s_waitcnt vmcnt(0)" ::: "memory"); \
          const unsigned og_ = XB_ADD(bar + 3328); const unsigned tg_ = og_ / nx; \
          if (og_ + 1u == (tg_ + 1u) * nx) XB_ADD(bar + 3392); else while (XB_LD(bar + 3392) == tg_) __builtin_amdgcn_s_sleep(1); \
          __builtin_amdgcn_fence(__ATOMIC_ACQUIRE, "agent"); \
          XB_ADD(bar + 2304 + 64 * xcc); \
          asm volatile("s_waitcnt vmcnt(0)" ::: "memory"); \
        } else { \
          while (XB_LD(bar + 2304 + 64 * xcc) == gen_) __builtin_amdgcn_s_sleep(1); \
          __builtin_amdgcn_fence(__ATOMIC_ACQUIRE, "agent"); asm volatile("s_waitcnt vmcnt(0)" ::: "memory"); \
        } } \
      __syncthreads(); } ++nbar; } while (0)
#define PHASE(body) do { if (ph >= p.ph_lo && ph < p.ph_hi) { body; if ((MK_DUPMASK >> ph) & 1ull) { GSYNC(); body; } if (ph + 1 < p.ph_hi) GSYNC(); } ++ph; } while (0)
#define ROWARGS(Y, gpost, mgate, donorm, gpre, msh, msc, init, skipc) (RowArgs{(Y), (gpost), (mgate), (donorm), (gpre), (msh), (msc), (init), (skipc), nullptr, 0, nullptr, nullptr})
#define ROWARGSP(Y, gpost, mgate, donorm, gpre, msh, msc, init, skipc, part, ks) (RowArgs{(Y), (gpost), (mgate), (donorm), (gpre), (msh), (msc), (init), (skipc), (part), (ks), nullptr, nullptr})
#define PARTB ((bf16_t*)(BIG + 190 * MiB))
#define MLP(L, LAST) do { \
    if (LAST) { PHASE((phase_gemm_lat<1>(lds, H, (const bf16_t*)(ws + WT_W1) + (size_t)(L) * DM * DFF, DFF, DM, (bf16_t*)BIG, DFF))); } \
    else { PHASE((phase_gemm<1>(lds, H, (const bf16_t*)(ws + WT_W1) + (size_t)(L) * DM * DFF, DFF, DM, (bf16_t*)BIG, DFF, nullptr, nullptr))); } \
    PHASE((phase_gemm_lat<0>(lds, (const bf16_t*)BIG, (const bf16_t*)(ws + WT_W2) + (size_t)(L) * DM * DFF, DM, DFF, (bf16_t*)(BIG + 144 * MiB), DM), \
           (LAST) ? (void)0 : phase_gemm_ctxsplit(lds, (const bf16_t*)BIG, (const bf16_t*)(ws + WT_W2) + (size_t)(L) * DM * DFF, DM, DFF, 8, PARTB))); \
    PHASE((phase_row(p, ROWARGSP((const bf16_t*)(BIG + 144 * MiB), (L) * 4 + 3, (L) * 6 + 5, (LAST) ? 0 : 1, ((L) + 1) * 4 + 0, ((L) + 1) * 6 + 0, ((L) + 1) * 6 + 1, 0, (LAST) ? 1 : 0, PARTB, 8)))); \
  } while (0)

  PHASE(phase_prep(p, lds));
  PHASE((phase_row(p, ROWARGS(nullptr, 0, 0, 1, 0, 0, 1, 1, 0)), s5_build_tables(p, lds)));
  { bf16_t* QKV = (bf16_t*)BIG; bf16_t* O = (bf16_t*)(BIG + 56 * MiB); bf16_t* Y = (bf16_t*)(BIG + 96 * MiB);
    PHASE((phase_gemm<0>(lds, H, (const bf16_t*)(ws + WT_GQKV), 1536, DM, QKV, 1536, nullptr, nullptr)));
    PHASE(phase_gqa_qknorm(p, QKV));
    PHASE(phase_gqa_attn(lds, QKV, O));
    PHASE((phase_gemm_lat<0>(lds, O, (const bf16_t*)(ws + WT_GO), DM, DM, Y, DM), phase_gemm_ctxsplit(lds, O, (const bf16_t*)(ws + WT_GO), DM, DM, 4, PARTB)));
    PHASE(phase_row(p, ROWARGSP(Y, 0 * 4 + 1, 0 * 6 + 2, 1, 0 * 4 + 2, 0 * 6 + 3, 0 * 6 + 4, 0, 0, PARTB, 4)));
    MLP(0, 0); }
  { bf16_t* G = (bf16_t*)BIG; bf16_t* Y = (bf16_t*)(BIG + 40 * MiB); bf16_t* SLOC = (bf16_t*)(BIG + 80 * MiB); bf16_t* SIN = (bf16_t*)(BIG + 152 * MiB);
    PHASE(phase_s5_local(p, lds, SLOC));
    PHASE(phase_s5_carry(p, SLOC, SIN));
    PHASE(phase_s5_full(p, lds, SIN, G));
    PHASE((phase_gemm_lat<2>(lds, G, (const bf16_t*)(ws + WT_GLU), DM, DM, Y, DM, p.in[22], G), phase_gemm_ctxsplit(lds, G, (const bf16_t*)(ws + WT_GLU), DM, DM, 4, PARTB)));
    PHASE(phase_row(p, (RowArgs{Y, 1 * 4 + 1, 1 * 6 + 2, 1, 1 * 4 + 2, 1 * 6 + 3, 1 * 6 + 4, 0, 0, PARTB, 4, G, p.in[22]})));
    MLP(1, 0); }
  { bf16_t* P1 = (bf16_t*)BIG; bf16_t* XBC = (bf16_t*)(BIG + 117 * MiB); bf16_t* YS = (bf16_t*)BIG; bf16_t* Y = (bf16_t*)(BIG + 72 * MiB); bf16_t* GATE = (bf16_t*)(BIG + 117 * MiB);
    PHASE((phase_gemm<0>(lds, H, (const bf16_t*)(ws + WT_SIN1), SSD_N1, DM, P1, SSD_N1, nullptr, nullptr)));
    PHASE(phase_ssd_conv(p, P1, XBC));
    PHASE(phase_ssd_scan(p, lds, XBC, YS));
    PHASE((phase_gemm_lat<0>(lds, H, (const bf16_t*)(ws + WT_SGATE), 2048, DM, GATE, 2048), phase_gemm_ctxsplit(lds, H, (const bf16_t*)(ws + WT_SGATE), 2048, DM, 4, PARTB)));
    PHASE(phase_ssd_gate(p, YS, GATE, PARTB));
    PHASE((phase_gemm_lat<0>(lds, YS, (const bf16_t*)(ws + WT_SOUT), DM, 2048, Y, DM), phase_gemm_ctxsplit(lds, YS, (const bf16_t*)(ws + WT_SOUT), DM, 2048, 8, PARTB)));
    PHASE(phase_row(p, ROWARGSP(Y, 2 * 4 + 1, 2 * 6 + 2, 1, 2 * 4 + 2, 2 * 6 + 3, 2 * 6 + 4, 0, 0, PARTB, 8)));
    MLP(2, 0); }
  { bf16_t* QKV = (bf16_t*)BIG; bf16_t* O = (bf16_t*)(BIG + 108 * MiB); bf16_t* Y = (bf16_t*)(BIG + 144 * MiB);
    PHASE((phase_gemm<0>(lds, H, (const bf16_t*)(ws + WT_NQKV), 3072, DM, QKV, 3072, nullptr, nullptr)));
    PHASE(phase_na_attn(p, lds, QKV, O));
    PHASE((phase_gemm_lat<0>(lds, O, (const bf16_t*)(ws + WT_NO), DM, DM, Y, DM)));
    PHASE(phase_row(p, ROWARGS(Y, 3 * 4 + 1, 3 * 6 + 2, 1, 3 * 4 + 2, 3 * 6 + 3, 3 * 6 + 4, 0, 1)));
    MLP(3, 1); }
}

constexpr int LDS_BYTES = 163840;
extern "C" void kernel_launch(void* const* d_in, const int* in_sizes, int n_in, void* d_out, int out_size, void* d_ws, size_t ws_size, hipStream_t stream) {
  static int grid = 0;
  if (grid == 0) {
    if (n_in != 34 || ws_size < WS_END || out_size != NB * SEQ * DM) { fprintf(stderr, "kernel_launch: unexpected shapes (n_in %d, ws %zu need %zu, out %d)\n", n_in, ws_size, (size_t)WS_END, out_size); grid = -1; return; }
    int dev = 0, cus = 0, per_cu = 0;
    hipGetDevice(&dev); hipDeviceGetAttribute(&cus, hipDeviceAttributeMultiprocessorCount, dev);
    if (hipFuncSetAttribute((const void*)mega_fwd, hipFuncAttributeMaxDynamicSharedMemorySize, LDS_BYTES) != hipSuccess) { fprintf(stderr, "kernel_launch: hipFuncSetAttribute failed\n"); grid = -1; return; }
    if (hipOccupancyMaxActiveBlocksPerMultiprocessor(&per_cu, (const void*)mega_fwd, 512, LDS_BYTES) != hipSuccess || per_cu < 1) { fprintf(stderr, "kernel_launch: occupancy query says %d\n", per_cu); grid = -1; return; }
    grid = cus;
  }
  if (grid < 0) return;
  if (hipMemsetAsync((unsigned char*)d_ws + WS_BAR, 0, 16384, stream) != hipSuccess) { fprintf(stderr, "kernel_launch: memset failed\n"); return; }
  Params p{};
  for (int i = 0; i < 34; ++i) p.in[i] = (const float*)d_in[i];
  p.out = (float*)d_out; p.ws = (unsigned char*)d_ws;
#if MK_MULTI
  for (int ph = 0; ph < NPHASE; ++ph) { p.ph_lo = ph; p.ph_hi = ph + 1; hipLaunchKernelGGL(mega_fwd, dim3(grid), dim3(512), LDS_BYTES, stream, p); }
#else
  p.ph_lo = 0; p.ph_hi = NPHASE;
  void* args[] = {&p};
  hipError_t e = hipLaunchCooperativeKernel((const void*)mega_fwd, dim3(grid), dim3(512), args, LDS_BYTES, stream);
  if (e != hipSuccess) fprintf(stderr, "cooperative launch failed: %s (grid %d)\n", hipGetErrorString(e), grid);
#endif
}
```
